# Optimizing an MI355X kernel written in HIP

```python
import math
import jax, jax.numpy as jnp
from jax import lax
import numpy as np

D_MODEL = 4096
BATCH = 4
SEQ = 4096
DEPTH = 1

PLE_DIM = 256
ATTN_HEAD_DIM = 128
ATTN_HEADS_PER_GROUP = 4
DILATED_GROUPS = ((128, 1), (512, 4), (2048, 16))
N_ATTN_GROUPS = len(DILATED_GROUPS)
N_ATTN_HEADS = N_ATTN_GROUPS * ATTN_HEADS_PER_GROUP
ATTN_WIDTH = N_ATTN_HEADS * ATTN_HEAD_DIM
ATTN_OUT_WIDTH = ATTN_HEADS_PER_GROUP * ATTN_HEAD_DIM
ATTN_BLOCK = 128
N_BUCKETS = 32
MAX_DISTANCE = 2048
RWKV_HEAD_DIM = 64
RWKV_WIDTH = D_MODEL // 2
RWKV_HEADS = RWKV_WIDTH // RWKV_HEAD_DIM
DECAY_LORA = 96
AAA_LORA = 96
GATE_LORA = 256
RWKV_IN_WIDTH = 3 * RWKV_WIDTH + DECAY_LORA + AAA_LORA + GATE_LORA
D_FF = 4 * D_MODEL
N_BRANCHES = 2
IN_WIDTH = 3 * ATTN_WIDTH + RWKV_IN_WIDTH + N_BRANCHES * D_MODEL
RMS_EPS = 1e-6
GN_EPS = 64e-5

kernel_name = "hybrid_dilated_attn_rwkv7_gated_block"


def rms_norm(x, gain):
    x32 = x.astype(jnp.float32)
    y = x32 * lax.rsqrt(jnp.mean(jnp.square(x32), axis=-1, keepdims=True) + RMS_EPS)
    return (y * gain.astype(jnp.float32)).astype(x.dtype)


def t5_bucket(dist):
    max_exact = N_BUCKETS // 2
    d_f = jnp.maximum(dist, 1).astype(jnp.float32)
    large = max_exact + (jnp.log(d_f / max_exact) / math.log(MAX_DISTANCE / max_exact)
                         * (N_BUCKETS - max_exact)).astype(jnp.int32)
    large = jnp.minimum(large, N_BUCKETS - 1)
    return jnp.where(dist < max_exact, dist, large)


def dilated_window_attention(q, k, v, bias_table, window, dilation):
    batch, seq, heads, hd = q.shape
    n_dist = window // dilation
    blk = ATTN_BLOCK
    span = dilation * blk
    s_pad = -(-seq // span) * span
    length = s_pad // dilation
    nb = length // blk

    def to_blocks(t):
        t = jnp.pad(t, ((0, 0), (0, s_pad - seq), (0, 0), (0, 0)))
        t = t.reshape(batch, length, dilation, heads, hd).transpose(0, 2, 3, 1, 4)
        return t.reshape(batch, dilation, heads, nb, blk, hd)

    def with_prev(t):
        prev = jnp.pad(t[:, :, :, :-1], ((0, 0), (0, 0), (0, 0), (1, 0), (0, 0), (0, 0)))
        return jnp.concatenate([prev, t], axis=4)

    qb = to_blocks(q).astype(jnp.float32)
    kb = with_prev(to_blocks(k)).astype(jnp.float32)
    vb = with_prev(to_blocks(v)).astype(jnp.float32)
    s = jnp.einsum('bdhnqe,bdhnke->bdhnqk', qb, kb) * (hd ** -0.5)

    q_idx = blk + jnp.arange(blk)
    k_idx = jnp.arange(2 * blk)
    rel = q_idx[:, None] - k_idx[None, :]
    band = (rel >= 0) & (rel <= n_dist)
    first = (jnp.arange(nb)[:, None, None] == 0) & (k_idx[None, None, :] < blk)
    valid = band[None] & ~first
    bucket = t5_bucket(jnp.maximum(rel, 0) * dilation)
    bias = jnp.transpose(bias_table[bucket].astype(jnp.float32), (2, 0, 1))
    s = jnp.where(valid, s + bias[:, None], -jnp.inf)

    m = jnp.max(s, axis=-1, keepdims=True)
    e = jnp.exp(s - m)
    l = jnp.sum(e, axis=-1, keepdims=True)
    o = jnp.einsum('bdhnqk,bdhnke->bdhnqe', e, vb) / l
    lse = (m + jnp.log(l))[..., 0]

    o = o.reshape(batch, dilation, heads, length, hd).transpose(0, 3, 1, 2, 4)
    o = o.reshape(batch, s_pad, heads, hd)[:, :seq]
    lse = lse.reshape(batch, dilation, heads, length).transpose(0, 3, 1, 2)
    lse = lse.reshape(batch, s_pad, heads)[:, :seq]
    return o, lse


def token_shift(z, mix):
    prev = jnp.pad(z, ((0, 0), (1, 0), (0, 0)))[:, :-1]
    return z + mix * (prev - z)


def rwkv7_time_mix(z, w0, w_decay_up, a0, w_aaa_up, w_gate_up, k_k, k_a, r_k, gn_w, gn_b):
    batch, seq, _ = z.shape
    f32 = jnp.float32
    z = z.astype(f32)
    c0 = RWKV_WIDTH
    r = z[..., :c0]
    k = z[..., c0:2 * c0]
    v = z[..., 2 * c0:3 * c0]
    xw = z[..., 3 * c0:3 * c0 + DECAY_LORA]
    xa = z[..., 3 * c0 + DECAY_LORA:3 * c0 + DECAY_LORA + AAA_LORA]
    xg = z[..., 3 * c0 + DECAY_LORA + AAA_LORA:]

    w = -jax.nn.softplus(-(w0.astype(f32) + jnp.tanh(xw) @ w_decay_up.astype(f32))) - 0.5
    a = jax.nn.sigmoid(a0.astype(f32) + xa @ w_aaa_up.astype(f32))
    g = jax.nn.sigmoid(xg) @ w_gate_up.astype(f32)
    decay = jnp.exp(-jnp.exp(w))

    hs = (batch, seq, RWKV_HEADS, RWKV_HEAD_DIM)
    kk = (k * k_k.astype(f32)).reshape(hs)
    kk = kk / jnp.maximum(jnp.linalg.norm(kk, axis=-1, keepdims=True), 1e-12)
    k = k * (1.0 + (a - 1.0) * k_a.astype(f32))
    r_h, k_h, v_h, a_h, d_h = (t.reshape(hs) for t in (r, k, v, a, decay))

    def step(state, inp):
        r_t, w_t, k_t, v_t, aa_t, bb_t = inp
        sa = jnp.einsum('bhij,bhj->bhi', state, aa_t)
        state = (state * w_t[:, :, None, :] + sa[..., None] * bb_t[:, :, None, :]
                 + v_t[..., None] * k_t[:, :, None, :])
        return state, jnp.einsum('bhij,bhj->bhi', state, r_t)

    xs = tuple(jnp.moveaxis(t, 1, 0) for t in (r_h, d_h, k_h, v_h, -kk, kk * a_h))
    state0 = jnp.zeros((batch, RWKV_HEADS, RWKV_HEAD_DIM, RWKV_HEAD_DIM), f32)
    _, y = lax.scan(step, state0, xs)
    y = jnp.moveaxis(y, 0, 1)

    mu = jnp.mean(y, axis=-1, keepdims=True)
    var = jnp.mean(jnp.square(y - mu), axis=-1, keepdims=True)
    y = ((y - mu) * lax.rsqrt(var + GN_EPS)).reshape(batch, seq, RWKV_WIDTH)
    y = (y * gn_w.astype(f32) + gn_b.astype(f32)).reshape(hs)
    y = y + jnp.sum(r_h * k_h * r_k.astype(f32), axis=-1, keepdims=True) * v_h
    return y.reshape(batch, seq, RWKV_WIDTH) * g


def setup_inputs(seed: int = 0) -> dict:
    key = jax.random.key(seed)
    ks = jax.random.split(key, 32)
    f32 = jnp.float32

    def nrm(k, shape, scale):
        return jax.random.normal(k, shape, f32) * scale

    def gain(k, shape):
        return 1.0 + 0.05 * jax.random.normal(k, shape, f32)

    L = DEPTH
    return {
        "x": nrm(ks[0], (BATCH, SEQ, D_MODEL), 1.0),
        "p": nrm(ks[1], (DEPTH, BATCH, SEQ, PLE_DIM), 1.0),
        "norm_mix": gain(ks[2], (L, D_MODEL)),
        "w_in": nrm(ks[3], (L, D_MODEL, IN_WIDTH), D_MODEL ** -0.5),
        "q_gain": gain(ks[4], (L, ATTN_HEAD_DIM)),
        "k_gain": gain(ks[5], (L, ATTN_HEAD_DIM)),
        "rel_bias": nrm(ks[6], (N_BUCKETS, N_ATTN_HEADS), 0.5),
        "w_attn_up": nrm(ks[7], (L, ATTN_OUT_WIDTH, D_MODEL), ATTN_OUT_WIDTH ** -0.5),
        "shift_mix": jax.random.uniform(ks[8], (L, RWKV_IN_WIDTH), f32),
        "w0": jax.random.uniform(ks[9], (L, RWKV_WIDTH), f32, minval=-5.0, maxval=1.0),
        "w_decay_up": nrm(ks[10], (L, DECAY_LORA, RWKV_WIDTH), DECAY_LORA ** -0.5),
        "a0": nrm(ks[11], (L, RWKV_WIDTH), 0.1),
        "w_aaa_up": nrm(ks[12], (L, AAA_LORA, RWKV_WIDTH), AAA_LORA ** -0.5),
        "w_gate_up": nrm(ks[13], (L, GATE_LORA, RWKV_WIDTH), GATE_LORA ** -0.5),
        "k_k": 0.85 + nrm(ks[14], (L, RWKV_WIDTH), 0.05),
        "k_a": gain(ks[15], (L, RWKV_WIDTH)),
        "r_k": nrm(ks[16], (L, RWKV_HEADS, RWKV_HEAD_DIM), 0.1),
        "gn_w": gain(ks[17], (L, RWKV_WIDTH)),
        "gn_b": nrm(ks[18], (L, RWKV_WIDTH), 0.02),
        "w_rwkv_up": nrm(ks[19], (L, RWKV_WIDTH, D_MODEL), RWKV_WIDTH ** -0.5),
        "w_out": nrm(ks[20], (L, D_MODEL, D_MODEL), D_MODEL ** -0.5),
        "norm_mlp": gain(ks[21], (L, D_MODEL)),
        "w_mlp_in": nrm(ks[22], (L, D_MODEL, D_FF), D_MODEL ** -0.5),
        "w_mlp_out": nrm(ks[23], (L, D_FF, D_MODEL), D_FF ** -0.5),
        "norm_ple": gain(ks[24], (L, D_MODEL)),
        "w_ple_gate": nrm(ks[25], (L, D_MODEL, D_MODEL), D_MODEL ** -0.5),
        "w_ple_proj": nrm(ks[26], (L, PLE_DIM, D_MODEL), PLE_DIM ** -0.5),
    }


def reference(x, p, norm_mix, w_in, q_gain, k_gain, rel_bias, w_attn_up, shift_mix, w0, w_decay_up,
              a0, w_aaa_up, w_gate_up, k_k, k_a, r_k, gn_w, gn_b, w_rwkv_up, w_out, norm_mlp,
              w_mlp_in, w_mlp_out, norm_ple, w_ple_gate, w_ple_proj):
    batch, seq, _ = x.shape
    a_end = 3 * ATTN_WIDTH
    r_end = a_end + RWKV_IN_WIDTH
    for i in range(DEPTH):
        h = rms_norm(x, norm_mix[i])
        proj = h @ w_in[i]
        qkv = proj[..., :a_end].reshape(batch, seq, 3, N_ATTN_HEADS, ATTN_HEAD_DIM)
        z = proj[..., a_end:r_end]
        gates = jax.nn.sigmoid(proj[..., r_end:]).reshape(batch, seq, N_BRANCHES, D_MODEL)

        q = rms_norm(qkv[:, :, 0], q_gain[i])
        k = rms_norm(qkv[:, :, 1], k_gain[i])
        v = qkv[:, :, 2]
        outs, lses = [], []
        for gi, (window, dilation) in enumerate(DILATED_GROUPS):
            sl = slice(gi * ATTN_HEADS_PER_GROUP, (gi + 1) * ATTN_HEADS_PER_GROUP)
            o, lse = dilated_window_attention(q[:, :, sl], k[:, :, sl], v[:, :, sl],
                                              rel_bias[:, sl], window, dilation)
            outs.append(o)
            lses.append(lse)
        mix_w = jax.nn.softmax(jnp.stack(lses, axis=0), axis=0)
        attn = jnp.sum(mix_w[..., None] * jnp.stack(outs, axis=0), axis=0)
        attn = attn.reshape(batch, seq, ATTN_OUT_WIDTH).astype(x.dtype)
        attn_d = attn @ w_attn_up[i]

        zs = token_shift(z, shift_mix[i])
        rw = rwkv7_time_mix(zs, w0[i], w_decay_up[i], a0[i], w_aaa_up[i], w_gate_up[i],
                            k_k[i], k_a[i], r_k[i], gn_w[i], gn_b[i]).astype(x.dtype)
        rwkv_d = rw @ w_rwkv_up[i]

        merged = gates[:, :, 0] * attn_d + gates[:, :, 1] * rwkv_d
        x = x + merged @ w_out[i]

        h = rms_norm(x, norm_mlp[i])
        x = x + jnp.square(jax.nn.relu(h @ w_mlp_in[i])) @ w_mlp_out[i]

        ple_gate = jax.nn.sigmoid(rms_norm(x, norm_ple[i]) @ w_ple_gate[i])
        x = x + ple_gate * (p[i] @ w_ple_proj[i])
    return x
```

```cpp
#include <hip/hip_runtime.h>
#include <cstdio>
#include <cstdint>
namespace pg8 {
#define PG8_LAS __attribute__((address_space(3)))
typedef unsigned short bf16_t;
typedef short bf16x8 __attribute__((ext_vector_type(8)));
typedef float f32x4 __attribute__((ext_vector_type(4)));
typedef unsigned u32x4 __attribute__((ext_vector_type(4)));
typedef unsigned u32x2 __attribute__((ext_vector_type(2)));
constexpr int BM = 256, BK = 64, HALF = 128, HTB = HALF * BK * 2  , STAGE_BYTES = 8 * HTB, NXCD = 8, WGM = 8;

__host__ __device__ __forceinline__ int lds_byte(int r, int c) { const int st = (r >> 4) * 2 + (c >> 5), rr = r & 15, cc = c & 31, ob = rr * 64 + cc * 2; return st * 1024 + (ob ^ (((ob >> 9) & 1) << 5)); }
__host__ __device__ __forceinline__ void stage_rc(int b, int& R, int& C) { const int st = b / 1024, sb = b % 1024, swz = sb ^ (((sb >> 9) & 1) << 5); R = (st >> 1) * 16 + swz / 64; C = (st & 1) * 32 + (swz % 64) / 2; }
__host__ __device__ __forceinline__ int perm32(int rho) { const int n = rho >> 4, i = rho & 15; return 8 * (i >> 2) + 4 * n + (i & 3); }

struct Unit { int pm, pn; };
struct Gemm { const bf16_t* A; const bf16_t* Bt; int M, N, K, lda, ldb; };

struct StaticOrder {
    int nM, nN, nwg, G, c;
    __host__ __device__ void init(int M, int N, int G_, int c_) { nM = M / BM; nN = N / BM; nwg = nM * nN; G = G_; c = c_; }
    __host__ __device__ bool next(int i, Unit& u) const {
        const long L = (long)i * G + c; if (L >= nwg) return false;
        int wgid = (int)L; { const int q = nwg / NXCD, r = nwg % NXCD, xcd = wgid % NXCD, off = wgid / NXCD; wgid = (xcd < r ? xcd * (q + 1) : r * (q + 1) + (xcd - r) * q) + off; }
        const int nig = WGM * nN, gid = wgid / nig, fm = gid * WGM, gsz = (nM - fm) < WGM ? (nM - fm) : WGM;
        u.pm = fm + ((wgid % nig) % gsz); u.pn = (wgid % nig) / gsz; return true;
    }
    __device__ __forceinline__ void a_ready(const Unit&) const {}
    __device__ __forceinline__ void done(const Unit&) const {}
};
__device__ __forceinline__ unsigned cvt_pk_bf16(float lo, float hi) { unsigned r; asm volatile("v_cvt_pk_bf16_f32 %0, %1, %2" : "=v"(r) : "v"(lo), "v"(hi)); return r; }
__device__ __forceinline__ float bf_lo(unsigned w) { return __builtin_bit_cast(float, w << 16); }
__device__ __forceinline__ float bf_hi(unsigned w) { return __builtin_bit_cast(float, w & 0xffff0000u); }
__device__ __forceinline__ float sigmoidf_(float x) { return __builtin_amdgcn_rcpf(1.0f + __builtin_amdgcn_exp2f(-1.4426950408889634f * x)); }

template <class Epi, class Sched, bool ALIGN_EPI = false, bool SP2 = false>
__device__ __forceinline__ void gemm_phase(PG8_LAS unsigned char* lds, const Gemm g, const Sched& S, const Epi& E) {
    const int tid = threadIdx.x, wid = __builtin_amdgcn_readfirstlane(tid >> 6), lane = tid & 63, wr = wid >> 2, wc = wid & 3, fr = lane & 15, fq = lane >> 4;
    const int K = g.K, nt = K / BK;
    unsigned voffA[2], voffB[2];
#pragma unroll
    for (int i = 0; i < 2; ++i) { int R, C; stage_rc(tid * 16 + i * 8192, R, C); const int Rb = Epi::PERM ? ((R & ~31) + perm32(R & 31)) : R;
        voffA[i] = (unsigned)(R * g.lda + C) * 2u; voffB[i] = (unsigned)(Rb * g.ldb + C) * 2u; }
    const size_t kstep = (size_t)(BK * 2);
    const size_t hstepA = (size_t)HALF * g.lda * 2, hstepB = (size_t)HALF * g.ldb * 2;
    const size_t tstepA = 2 * hstepA, tstepB = 2 * hstepB;
    const unsigned ldsw = (unsigned)wid * 1024u;
    const int aoff = lds_byte(wr * 64 + fr, fq * 8), boff = lds_byte(wc * 32 + fr, fq * 8);
#define PG8_SA(b, h) (((b) * 2 + (h)) * HTB)
#define PG8_SB(b, h) ((4 + (b) * 2 + (h)) * HTB)
#define PG8_STAGE(bufoff, gbase, voff) do { _Pragma("unroll") for (int _i = 0; _i < 2; ++_i) \
        __builtin_amdgcn_global_load_lds((const unsigned*)((const char*)(gbase) + (voff)[_i]), (PG8_LAS unsigned*)(lds + (bufoff) + ldsw + _i * 8192), 16, 0, 0); } while (0)
#define PG8_LDA(dst, b, h) do { _Pragma("unroll") for (int m = 0; m < 4; ++m) _Pragma("unroll") for (int k = 0; k < 2; ++k) dst[m][k] = *(const PG8_LAS bf16x8*)(lds + PG8_SA(b, h) + aoff + m * 2048 + k * 1024); } while (0)
#define PG8_LDB(dst, b, h) do { _Pragma("unroll") for (int n = 0; n < 2; ++n) _Pragma("unroll") for (int k = 0; k < 2; ++k) dst[n][k] = *(const PG8_LAS bf16x8*)(lds + PG8_SB(b, h) + boff + n * 2048 + k * 1024); } while (0)
#define PG8_MMA(ai, bj, At, Bt) do { __builtin_amdgcn_s_setprio(1); _Pragma("unroll") for (int m = 0; m < 4; ++m) _Pragma("unroll") for (int n = 0; n < 2; ++n) _Pragma("unroll") for (int k = 0; k < 2; ++k) \
        acc[ai][bj][m][n] = __builtin_amdgcn_mfma_f32_16x16x32_bf16(Bt[n][k], At[m][k], acc[ai][bj][m][n], 0, 0, 0); __builtin_amdgcn_s_setprio(0); } while (0)
#define PG8_WAIT_V(n) asm volatile("s_waitcnt vmcnt(" #n ")" ::: "memory")
#define PG8_WAIT_L(n) asm volatile("s_waitcnt lgkmcnt(" #n ")" ::: "memory")
#define PG8_BAR __builtin_amdgcn_s_barrier()
#define PG8_SCHED __builtin_amdgcn_sched_barrier(0)
    Unit cur, nxt; int ui = 0;
    if (!S.next(0, cur)) return;
    f32x4 acc[2][2][4][2];
#pragma unroll
    for (int a = 0; a < 2; ++a)
#pragma unroll
        for (int b = 0; b < 2; ++b)
#pragma unroll
            for (int m = 0; m < 4; ++m)
#pragma unroll
                for (int n = 0; n < 2; ++n) acc[a][b][m][n] = (f32x4){0.f, 0.f, 0.f, 0.f};
    bf16x8 At[4][2], B0[2][2], B1[2][2];
    const char* cA = (const char*)g.A + (size_t)cur.pm * tstepA; const char* cB = (const char*)g.Bt + (size_t)cur.pn * tstepB;
    S.a_ready(cur);
    if constexpr (SP2) {
        PG8_STAGE(PG8_SB(0, 0), cB, voffB); PG8_STAGE(PG8_SB(0, 1), cB + hstepB, voffB); PG8_STAGE(PG8_SA(0, 0), cA, voffA); PG8_STAGE(PG8_SA(0, 1), cA + hstepA, voffA);
        if (wr == 1) PG8_BAR;
        PG8_WAIT_V(2); PG8_BAR;
        PG8_STAGE(PG8_SB(1, 0), cB + kstep, voffB); PG8_STAGE(PG8_SA(1, 0), cA + kstep, voffA); PG8_STAGE(PG8_SB(1, 1), cB + hstepB + kstep, voffB);
        PG8_WAIT_V(6); PG8_BAR;
    } else {
        PG8_STAGE(PG8_SB(0, 0), cB, voffB); PG8_STAGE(PG8_SA(0, 0), cA, voffA); PG8_STAGE(PG8_SB(0, 1), cB + hstepB, voffB); PG8_STAGE(PG8_SA(0, 1), cA + hstepA, voffA);
        if (wr == 1) PG8_BAR;
        PG8_WAIT_V(4); PG8_BAR;
        PG8_STAGE(PG8_SB(1, 0), cB + kstep, voffB); PG8_STAGE(PG8_SA(1, 0), cA + kstep, voffA); PG8_STAGE(PG8_SB(1, 1), cB + hstepB + kstep, voffB);
        PG8_WAIT_V(6); PG8_BAR;
    }
    for (;;) {
        const bool has_next = S.next(ui + 1, nxt);
        const char* nA = has_next ? (const char*)g.A + (size_t)nxt.pm * tstepA : cA; const char* nB = has_next ? (const char*)g.Bt + (size_t)nxt.pn * tstepB : cB;
        for (int t = 0; t < nt; t += 2) {
            const bool last = (t == nt - 2);
            const char* a1 = cA + (size_t)(t + 1) * kstep;
            const char* a2 = last ? nA : cA + (size_t)(t + 2) * kstep; const char* b2 = last ? nB : cB + (size_t)(t + 2) * kstep;
            const char* a3 = a2 + kstep; const char* b3 = b2 + kstep;
            if (last && has_next) S.a_ready(nxt);
            if constexpr (SP2) {
            PG8_LDB(B0, 0, 0); PG8_LDB(B1, 0, 1); PG8_SCHED; PG8_LDA(At, 0, 0); PG8_STAGE(PG8_SA(1, 1), a1 + hstepA, voffA);
            PG8_WAIT_V(8); PG8_WAIT_L(0); PG8_BAR; PG8_MMA(0, 0, At, B0); PG8_MMA(0, 1, At, B1); PG8_BAR; PG8_SCHED;
            PG8_LDA(At, 0, 1); PG8_STAGE(PG8_SB(0, 0), b2, voffB); PG8_STAGE(PG8_SB(0, 1), b2 + hstepB, voffB); PG8_STAGE(PG8_SA(0, 0), a2, voffA);
            PG8_WAIT_V(8); PG8_WAIT_L(0); PG8_BAR; PG8_MMA(1, 0, At, B0); PG8_MMA(1, 1, At, B1); PG8_BAR; PG8_SCHED;
            PG8_LDB(B0, 1, 0); PG8_LDB(B1, 1, 1); PG8_SCHED; PG8_LDA(At, 1, 0); PG8_STAGE(PG8_SA(0, 1), a2 + hstepA, voffA);
            PG8_WAIT_V(8); PG8_WAIT_L(0); PG8_BAR; PG8_MMA(0, 0, At, B0); PG8_MMA(0, 1, At, B1); PG8_BAR; PG8_SCHED;
            PG8_LDA(At, 1, 1); PG8_STAGE(PG8_SB(1, 0), b3, voffB); PG8_STAGE(PG8_SB(1, 1), b3 + hstepB, voffB); PG8_STAGE(PG8_SA(1, 0), a3, voffA);
            PG8_WAIT_V(8); PG8_WAIT_L(0); PG8_BAR; PG8_MMA(1, 0, At, B0); PG8_MMA(1, 1, At, B1); PG8_BAR; PG8_SCHED;
            } else {
            PG8_LDB(B0, 0, 0); PG8_SCHED; PG8_LDA(At, 0, 0); PG8_STAGE(PG8_SA(1, 1), a1 + hstepA, voffA);
            PG8_WAIT_L(8); PG8_BAR; PG8_WAIT_L(0); PG8_MMA(0, 0, At, B0); PG8_BAR; PG8_SCHED;
            PG8_LDB(B1, 0, 1); PG8_STAGE(PG8_SB(0, 0), b2, voffB);
            PG8_BAR; PG8_WAIT_L(0); PG8_MMA(0, 1, At, B1); PG8_BAR;
            PG8_LDA(At, 0, 1); PG8_STAGE(PG8_SA(0, 0), a2, voffA);
            PG8_BAR; PG8_WAIT_L(0); PG8_MMA(1, 0, At, B0); PG8_BAR; PG8_SCHED;
            PG8_STAGE(PG8_SB(0, 1), b2 + hstepB, voffB);
            PG8_WAIT_V(6); PG8_BAR; PG8_MMA(1, 1, At, B1); PG8_BAR;
            PG8_LDB(B0, 1, 0); PG8_SCHED; PG8_LDA(At, 1, 0); PG8_STAGE(PG8_SA(0, 1), a2 + hstepA, voffA);
            PG8_WAIT_L(8); PG8_BAR; PG8_WAIT_L(0); PG8_MMA(0, 0, At, B0); PG8_BAR; PG8_SCHED;
            PG8_LDB(B1, 1, 1); PG8_STAGE(PG8_SB(1, 0), b3, voffB);
            PG8_BAR; PG8_WAIT_L(0); PG8_MMA(0, 1, At, B1); PG8_BAR;
            PG8_LDA(At, 1, 1); PG8_STAGE(PG8_SA(1, 0), a3, voffA);
            PG8_BAR; PG8_WAIT_L(0); PG8_MMA(1, 0, At, B0); PG8_BAR; PG8_SCHED;
            PG8_STAGE(PG8_SB(1, 1), b3 + hstepB, voffB);
            PG8_WAIT_V(6); PG8_BAR; PG8_MMA(1, 1, At, B1); PG8_BAR;
            }
        }
        if constexpr (ALIGN_EPI) { if (wr == 0) PG8_BAR; }
        if constexpr (!Epi::AFTER_DRAIN) { E(acc, cur, wr, wc, fr, fq); S.done(cur); }
        if (!has_next) break;
#pragma unroll
        for (int a = 0; a < 2; ++a)
#pragma unroll
            for (int b = 0; b < 2; ++b)
#pragma unroll
                for (int m = 0; m < 4; ++m)
#pragma unroll
                    for (int n = 0; n < 2; ++n) acc[a][b][m][n] = (f32x4){0.f, 0.f, 0.f, 0.f};
        cur = nxt; cA = nA; cB = nB; ++ui;
        if constexpr (ALIGN_EPI) { if (wr == 1) PG8_BAR; }
    }
    PG8_WAIT_V(0);
    if constexpr (!ALIGN_EPI) { if (wr == 0) PG8_BAR; }
    PG8_BAR;
    if constexpr (Epi::AFTER_DRAIN) { E.fused(acc, cur, wr, wc, fr, fq, lds, wid, lane); S.done(cur); }
#undef PG8_SA
#undef PG8_SB
#undef PG8_STAGE
#undef PG8_LDA
#undef PG8_LDB
#undef PG8_MMA
#undef PG8_WAIT_V
#undef PG8_WAIT_L
#undef PG8_BAR
#undef PG8_SCHED
}

typedef const f32x4 (&AccRef)[2][2][4][2];
__device__ __forceinline__ u32x4 pack8(const f32x4 v0, const f32x4 v1) { u32x4 w; w.x = cvt_pk_bf16(v0[0], v0[1]); w.y = cvt_pk_bf16(v0[2], v0[3]); w.z = cvt_pk_bf16(v1[0], v1[1]); w.w = cvt_pk_bf16(v1[2], v1[3]); return w; }
__device__ __forceinline__ void unpack8(const u32x4 w, f32x4& v0, f32x4& v1) { v0 = (f32x4){bf_lo(w.x), bf_hi(w.x), bf_lo(w.y), bf_hi(w.y)}; v1 = (f32x4){bf_lo(w.z), bf_hi(w.z), bf_lo(w.w), bf_hi(w.w)}; }
__device__ __forceinline__ f32x4 sig4(const f32x4 v) { return (f32x4){sigmoidf_(v[0]), sigmoidf_(v[1]), sigmoidf_(v[2]), sigmoidf_(v[3])}; }

struct EpiWin {
    static constexpr bool PERM = true, AFTER_DRAIN = false;
    bf16_t* QKV; bf16_t* Z; bf16_t* GT; const float* rstd;
    __device__ __forceinline__ void operator()(AccRef acc, const Unit& u, int wr, int wc, int fr, int fq) const {
        const int row0 = u.pm * BM + wr * 64 + fr;
        bf16_t* base; int ldc, colt; bool sg = false;
        if (u.pn < 18) { base = QKV; ldc = 4608; colt = u.pn * 256; }
        else if (u.pn < 44) { base = Z; ldc = 6656; colt = (u.pn - 18) * 256; }
        else { base = GT; ldc = 8192; colt = (u.pn - 44) * 256; sg = true; }
        const int col0 = colt + wc * 32 + 8 * fq;
#pragma unroll
        for (int ai = 0; ai < 2; ++ai)
#pragma unroll
            for (int m = 0; m < 4; ++m) { const int r = row0 + ai * HALF + m * 16; const float rs = rstd[r]; bf16_t* rowp = base + (size_t)r * ldc + col0;
#pragma unroll
                for (int bj = 0; bj < 2; ++bj) { f32x4 v0 = acc[ai][bj][m][0] * rs, v1 = acc[ai][bj][m][1] * rs;
                    if (sg) { v0 = sig4(v0); v1 = sig4(v1); }
                    *(u32x4*)(rowp + bj * HALF) = pack8(v0, v1); } }
    }
};
struct EpiLora {
    static constexpr bool PERM = true, AFTER_DRAIN = false;
    bf16_t* EAG; const float* w0; const float* a0; size_t third_stride;
    __device__ __forceinline__ void operator()(AccRef acc, const Unit& u, int wr, int wc, int fr, int fq) const {
        const int row0 = u.pm * BM + wr * 64 + fr, third = u.pn >> 3, colt = (u.pn & 7) * 256;
        bf16_t* base = EAG + (size_t)third * third_stride;
        const int col0 = colt + wc * 32 + 8 * fq;
        const float* bvec = third == 0 ? w0 : a0;
        f32x4 bv[2][2];
#pragma unroll
        for (int bj = 0; bj < 2; ++bj)
#pragma unroll
            for (int n = 0; n < 2; ++n) bv[bj][n] = third < 2 ? *(const f32x4*)(bvec + col0 + bj * HALF + 4 * n) : (f32x4){0.f, 0.f, 0.f, 0.f};
        const float mul = third == 0 ? 0.6065306597126334f : 1.0f;
#pragma unroll
        for (int ai = 0; ai < 2; ++ai)
#pragma unroll
            for (int m = 0; m < 4; ++m) { const int r = row0 + ai * HALF + m * 16; bf16_t* rowp = base + (size_t)r * 2048 + col0;
#pragma unroll
                for (int bj = 0; bj < 2; ++bj) { f32x4 v0 = acc[ai][bj][m][0] + bv[bj][0], v1 = acc[ai][bj][m][1] + bv[bj][1];
                    if (third < 2) { v0 = sig4(v0) * mul; v1 = sig4(v1) * mul; }
                    *(u32x4*)(rowp + bj * HALF) = pack8(v0, v1); } }
    }
};
template <int MODE> struct EpiB {
    static constexpr bool PERM = true, AFTER_DRAIN = false;
    bf16_t* O; int ldc; const float* rstd; const bf16_t* GT; const bf16_t* AD;
    __device__ __forceinline__ void operator()(AccRef acc, const Unit& u, int wr, int wc, int fr, int fq) const {
        const int row0 = u.pm * BM + wr * 64 + fr, col0 = u.pn * BM + wc * 32 + 8 * fq;
#pragma unroll
        for (int ai = 0; ai < 2; ++ai)
#pragma unroll
            for (int m = 0; m < 4; ++m) { const int r = row0 + ai * HALF + m * 16; bf16_t* rowp = O + (size_t)r * ldc + col0;
                float rs = 1.f; if (MODE == 1) rs = rstd[r];
#pragma unroll
                for (int bj = 0; bj < 2; ++bj) { f32x4 v0 = acc[ai][bj][m][0], v1 = acc[ai][bj][m][1];
                    if (MODE == 1) { v0 = v0 * rs; v1 = v1 * rs;
#pragma unroll
                        for (int j = 0; j < 4; ++j) { const float a = v0[j] > 0.f ? v0[j] : 0.f, b = v1[j] > 0.f ? v1[j] : 0.f; v0[j] = a * a; v1[j] = b * b; } }
                    if (MODE == 2) { f32x4 g0, g1; unpack8(*(const u32x4*)(GT + (size_t)r * 8192 + col0 + bj * HALF), g0, g1); v0 = v0 * g0; v1 = v1 * g1; }
                    if (MODE == 3) { f32x4 g0, g1, a0, a1; unpack8(*(const u32x4*)(GT + (size_t)r * 8192 + 4096 + col0 + bj * HALF), g0, g1); unpack8(*(const u32x4*)(AD + (size_t)r * 4096 + col0 + bj * HALF), a0, a1);
                        v0 = a0 + v0 * g0; v1 = a1 + v1 * g1; }
                    *(u32x4*)(rowp + bj * HALF) = pack8(v0, v1); } }
    }
};
template <int MODE> struct EpiF {
    static constexpr bool PERM = false, AFTER_DRAIN = false;
    const float* res; float* out; const float* rstd; const bf16_t* PP;
    __device__ __forceinline__ void operator()(AccRef acc, const Unit& u, int wr, int wc, int fr, int fq) const {
        const int row0 = u.pm * BM + wr * 64 + fr, col0 = u.pn * BM + wc * 32 + 4 * fq;
#pragma unroll
        for (int ai = 0; ai < 2; ++ai)
#pragma unroll
            for (int m = 0; m < 4; ++m) { const int r = row0 + ai * HALF + m * 16; const size_t off = (size_t)r * 4096 + col0;
                float rs = 1.f; if (MODE == 1) rs = rstd[r];
#pragma unroll
                for (int bj = 0; bj < 2; ++bj)
#pragma unroll
                    for (int n = 0; n < 2; ++n) { const size_t o = off + bj * HALF + n * 16; const f32x4 b = *(const f32x4*)(res + o); f32x4 v = acc[ai][bj][m][n];
                        if (MODE == 1) { const u32x2 pw = *(const u32x2*)(PP + o); const f32x4 pp = (f32x4){bf_lo(pw.x), bf_hi(pw.x), bf_lo(pw.y), bf_hi(pw.y)}; v = sig4(v * rs) * pp; }
                        *(f32x4*)(out + o) = b + v; }
                asm volatile("" ::: "memory"); }
    }
};

}
constexpr int NWAVES = 8;
constexpr int SEQ = 4096, M = 16384, D = 4096;
constexpr int NQKV = 4608, NZP = 6656, NGT = 8192, NINP = 19456, NIN = 19392;
constexpr int RWW = 2048, DFF = 16384, PLE = 256, AOW = 512, LORAK = 512, LORAN = 6144;
#ifndef MK_ONE_LAUNCH
#define MK_ONE_LAUNCH 0
#endif
constexpr int NPH = 15;
enum { P_PRO = 0, G_WIN, T_QKN, G_LORA, T_ATTN, T_SCAN, G_ATTUP, G_RWUP, G_OUT, T_N2, G_MLPIN, G_MLPOUT, T_N3, G_PP, G_PLE };

constexpr size_t MiB = 1u << 20;
constexpr size_t WS_CTL = 0, CTL_ZERO_BYTES = 1 * MiB;
constexpr size_t WS_WIN = 2 * MiB;
constexpr size_t WS_WMLPIN = 2 * MiB;
constexpr size_t WS_WATT = 154 * MiB;
constexpr size_t WS_WLORA = 158 * MiB;
constexpr size_t WS_WRW = 164 * MiB;
constexpr size_t WS_WOUT = 180 * MiB;
constexpr size_t WS_XB = 212 * MiB;
constexpr size_t WS_QKV = 340 * MiB;
constexpr size_t WS_AD = 340 * MiB;
constexpr size_t WS_Z = 484 * MiB;
constexpr size_t WS_MERGED = 484 * MiB;
constexpr size_t WS_GT = 692 * MiB;
constexpr size_t WS_ATT = 948 * MiB;
constexpr size_t WS_RW = 964 * MiB;
constexpr size_t WS_EAG = 1028 * MiB;
constexpr size_t WS_ALORA = 1220 * MiB;
constexpr size_t WS_RSTD = 1236 * MiB;
constexpr size_t WS_PB = 1237 * MiB;
constexpr size_t WS_HID = 340 * MiB;
constexpr size_t WS_WMLPOUT = 852 * MiB;
constexpr size_t WS_WPLEG = 980 * MiB;
constexpr size_t WS_WPLEP = 1012 * MiB;
constexpr size_t WS_PP = 1014 * MiB;
constexpr size_t WS_END = 1245 * MiB;
constexpr int CW_BAR = 4096;

constexpr int RING_OFF = 0, RING_BYTES = 131072;
constexpr int LDSCTL_OFF = RING_BYTES, MISC_OFF = LDSCTL_OFF + 320;
constexpr int LDS_BYTES = 147456;

#define GAS __attribute__((address_space(1)))
#define LAS __attribute__((address_space(3)))
typedef unsigned short bf16;
typedef unsigned v4u __attribute__((ext_vector_type(4)));
typedef unsigned v2u __attribute__((ext_vector_type(2)));
typedef float f32x4 __attribute__((ext_vector_type(4)));
typedef GAS unsigned gu32;
#define RLX_AGENT __ATOMIC_RELAXED, __HIP_MEMORY_SCOPE_AGENT
#define LDS_WAIT() asm volatile("s_waitcnt lgkmcnt(0)" ::: "memory")
__device__ __forceinline__ unsigned f2bf(float f) { unsigned u = __builtin_bit_cast(unsigned, f); return (u + 0x7fffu + ((u >> 16) & 1u)) >> 16; }
__device__ __forceinline__ unsigned pk2(float lo, float hi) { return f2bf(lo) | (f2bf(hi) << 16); }
__device__ __forceinline__ float blo(unsigned w) { return __builtin_bit_cast(float, w << 16); }
__device__ __forceinline__ float bhi(unsigned w) { return __builtin_bit_cast(float, w & 0xffff0000u); }
__device__ __forceinline__ float bf1(bf16 h) { return __builtin_bit_cast(float, (unsigned)h << 16); }

#define XB_TMO      128
#define XB_XCNT(j)  (256  + 64 * (j))
#define XB_XSUB(j)  (1280 + 64 * (j))
#define XB_XGEN(j)  (2304 + 64 * (j))
#define XB_TOP      3328
#define XB_TOPGEN   3392
#define XCD_BAR_WORDS 3456
#define XB_SPIN_CAP (1u << 18)

__device__ __forceinline__ unsigned xb_ld(unsigned* p)              { return __hip_atomic_load(p, __ATOMIC_RELAXED, __HIP_MEMORY_SCOPE_AGENT); }
__device__ __forceinline__ unsigned xb_add(unsigned* p, unsigned v) { return __hip_atomic_fetch_add(p, v, __ATOMIC_RELAXED, __HIP_MEMORY_SCOPE_AGENT); }
__device__ __forceinline__ unsigned xb_xcc_id() { return (unsigned)__builtin_amdgcn_s_getreg((3 << 11) | 20) & 0xFu; }
#define XB_SPIN(cond, bar) do { unsigned _sp = 0; while (cond) { __builtin_amdgcn_s_sleep(1); \
    if ((++_sp & 255u) == 0u) { if (xb_ld(&(bar)[XB_TMO])) break; if (_sp > XB_SPIN_CAP) { atomicAdd(&(bar)[XB_TMO], 1u); break; } } } } while (0)

struct XcdBarrier {
    unsigned* bar; unsigned x;
    volatile LAS unsigned* st;
};

__device__ __forceinline__ XcdBarrier xcd_barrier_post(unsigned* bar, volatile LAS unsigned* st) {
    XcdBarrier b; b.bar = bar; b.x = xb_xcc_id(); b.st = st;
    if (threadIdx.x == 0) (void)xb_add(&bar[XB_XCNT(b.x)], 1u);
    return b;
}
__device__ __forceinline__ void xcd_barrier_complete(unsigned* bar, unsigned x, unsigned& nloc, unsigned& nx) {
    const unsigned G = gridDim.x * gridDim.y * gridDim.z;
    unsigned sum, cnt, mine, sp = 0u;
    for (;;) {
        sum = 0u; cnt = 0u; mine = 0u;
#pragma unroll
        for (unsigned j = 0; j < 16; ++j) { const unsigned c = xb_ld(&bar[XB_XCNT(j)]); sum += c; cnt += (c > 0u) ? 1u : 0u; mine = (j == x) ? c : mine; }
        if (sum == G) break;
        __builtin_amdgcn_s_sleep(1);
        if ((++sp & 255u) == 0u) { if (xb_ld(&bar[XB_TMO])) break; if (sp > XB_SPIN_CAP) { atomicAdd(&bar[XB_TMO], 1u); break; } }
    }
    nloc = mine > 0u ? mine : 1u; nx = cnt > 0u ? cnt : 1u;
}

__device__ __forceinline__ void xcd_barrier(const XcdBarrier& b) {
    asm volatile("s_waitcnt vmcnt(0)" ::: "memory");
    __syncthreads();
    if (threadIdx.x == 0) {
        unsigned* bar = b.bar;
        __builtin_amdgcn_s_waitcnt(0);
        unsigned nloc = b.st[0], nx = b.st[1];
        if (nloc == 0u) { xcd_barrier_complete(bar, b.x, nloc, nx); b.st[0] = nloc; b.st[1] = nx; }
        const unsigned old = xb_add(&bar[XB_XSUB(b.x)], 1u);
        const unsigned gen = old / nloc;
        if (old + 1u == (gen + 1u) * nloc) {
            __builtin_amdgcn_fence(__ATOMIC_RELEASE, "agent");
            asm volatile("s_waitcnt vmcnt(0)" ::: "memory");
            const unsigned og = xb_add(&bar[XB_TOP], 1u);
            const unsigned tg = og / nx;
            if (og + 1u == (tg + 1u) * nx) xb_add(&bar[XB_TOPGEN], 1u);
            else XB_SPIN(xb_ld(&bar[XB_TOPGEN]) == tg, bar);
            __builtin_amdgcn_fence(__ATOMIC_ACQUIRE, "agent");
            xb_add(&bar[XB_XGEN(b.x)], 1u);
            asm volatile("s_waitcnt vmcnt(0)" ::: "memory");
        } else {
            XB_SPIN(xb_ld(&bar[XB_XGEN(b.x)]) == gen, bar);
            __builtin_amdgcn_fence(__ATOMIC_ACQUIRE, "agent");
            asm volatile("s_waitcnt vmcnt(0)" ::: "memory");
        }
    }
    __syncthreads();
}
struct Frame {
    LAS unsigned char* lds;
    volatile LAS unsigned* MISC;
    gu32* ctl;
    int tid, lane, wave;
    int vcu, G;
    const float* in[27];
    float* out;
    unsigned char* ws;
};
__device__ __forceinline__ float wave_sum(float v) {
#pragma unroll
    for (int o = 1; o < 64; o <<= 1) v += __shfl_xor(v, o);
    return v;
}
__device__ __forceinline__ void transpose_item(const float* W, int K, int N, bf16* WT, const float* gk, int pad_from, int pad, LAS float* scr, int item, int lane) {
    const int nblk = N / 32, kb = item / nblk, nb = item % nblk, k0 = 64 * kb, n0 = 32 * nb;
#pragma unroll 8
    for (int i = 0; i < 32; ++i) { const int kk = 2 * i + (lane >> 5); float w = W[(size_t)(k0 + kk) * N + n0 + (lane & 31)]; if (gk) w *= gk[k0 + kk]; scr[kk * 33 + (lane & 31)] = w; }
    LDS_WAIT(); asm volatile("" ::: "memory");
    const int c = lane & 7;
    const int roff = n0 >= pad_from ? pad : 0;
#pragma unroll
    for (int j = 0; j < 4; ++j) { const int n = (lane >> 3) + 8 * j; const LAS float* s = scr + (8 * c) * 33 + n;
        v4u o; o.x = pk2(s[0 * 33], s[1 * 33]); o.y = pk2(s[2 * 33], s[3 * 33]); o.z = pk2(s[4 * 33], s[5 * 33]); o.w = pk2(s[6 * 33], s[7 * 33]);
        *(v4u*)(WT + (size_t)(roff + n0 + n) * K + k0 + 8 * c) = o; }
    LDS_WAIT(); asm volatile("" ::: "memory");
}
__device__ __forceinline__ void transpose_matrix(Frame& F, const float* W, int K, int N, bf16* WT, const float* gk, int pad_from, int pad) {
    LAS float* scr = (LAS float*)(F.lds + RING_OFF + F.wave * 16384);
    const int gw = F.vcu * NWAVES + F.wave, NGW = F.G * NWAVES, nitems = (K / 64) * (N / 32);
    for (int it = gw; it < nitems; it += NGW) transpose_item(W, K, N, WT, gk, pad_from, pad, scr, it, F.lane);
}
__device__ __forceinline__ void row_to_bf16_rstd(const float* xrow, bf16* orow, float* rstd_out, int lane) {
    const f32x4* xr = (const f32x4*)xrow + lane;
    f32x4 v[16]; float s = 0.f;
#pragma unroll
    for (int j = 0; j < 16; ++j) { v[j] = xr[64 * j]; s += (v[j].x * v[j].x + v[j].y * v[j].y) + (v[j].z * v[j].z + v[j].w * v[j].w); }
    s = wave_sum(s);
    v2u* o8 = (v2u*)orow + lane;
#pragma unroll
    for (int j = 0; j < 16; ++j) { v2u w; w.x = pk2(v[j].x, v[j].y); w.y = pk2(v[j].z, v[j].w); o8[64 * j] = w; }
    if (lane == 0) *rstd_out = 1.0f / sqrtf(s * (1.0f / 4096.0f) + 1e-6f);
}
__device__ __forceinline__ void rows_to_bf16_rstd(Frame& F, const float* X, bf16* XB, float* rstd) {
    const int gw = F.vcu * NWAVES + F.wave, NGW = F.G * NWAVES;
    for (int m = gw; m < M; m += NGW) row_to_bf16_rstd(X + (size_t)m * D, XB + (size_t)m * D, rstd + m, F.lane);
}

__device__ __forceinline__ void p_prologue(Frame& F) {
    unsigned char* ws = F.ws;
    transpose_matrix(F, F.in[3], D, NIN, (bf16*)(ws + WS_WIN), F.in[2], 11200, 64);
    transpose_matrix(F, F.in[7], AOW, D, (bf16*)(ws + WS_WATT), nullptr, 1 << 30, 0);
    transpose_matrix(F, F.in[19], RWW, D, (bf16*)(ws + WS_WRW), nullptr, 1 << 30, 0);
    transpose_matrix(F, F.in[20], D, D, (bf16*)(ws + WS_WOUT), nullptr, 1 << 30, 0);
    const size_t gt = (size_t)blockIdx.x * 512 + F.tid, NT = (size_t)F.G * 512;
    { v4u* z = (v4u*)((bf16*)(ws + WS_WIN) + (size_t)11200 * D); for (size_t i = gt; i < (size_t)64 * D / 8; i += NT) z[i] = (v4u){0u, 0u, 0u, 0u}; }
    {
        const float* wd = F.in[10]; const float* wa = F.in[12]; const float* wg = F.in[13]; bf16* WL = (bf16*)(ws + WS_WLORA);
        for (size_t i = gt; i < (size_t)LORAN * 64; i += NT) { const int n = (int)(i % LORAN), k8 = (int)(i / LORAN) * 8, third = n >> 11, c = n & 2047; float v[8];
#pragma unroll
            for (int j = 0; j < 8; ++j) { const int k = k8 + j; float x = 0.f;
                if (third == 0) { if (k < 96) x = wd[(size_t)k * 2048 + c]; }
                else if (third == 1) { if (k >= 96 && k < 192) x = wa[(size_t)(k - 96) * 2048 + c]; }
                else { if (k >= 192 && k < 448) x = wg[(size_t)(k - 192) * 2048 + c]; }
                v[j] = x; }
            v4u o; o.x = pk2(v[0], v[1]); o.y = pk2(v[2], v[3]); o.z = pk2(v[4], v[5]); o.w = pk2(v[6], v[7]);
            *(v4u*)(WL + (size_t)n * LORAK + k8) = o; } }
    {
        const f32x4* p4 = (const f32x4*)F.in[1]; v2u* pb = (v2u*)(ws + WS_PB);
        for (size_t i = gt; i < (size_t)M * PLE / 4; i += NT) { const f32x4 v = p4[i]; v2u w; w.x = pk2(v.x, v.y); w.y = pk2(v.z, v.w); pb[i] = w; } }
    rows_to_bf16_rstd(F, F.in[0], (bf16*)(ws + WS_XB), (float*)(ws + WS_RSTD));
}

__device__ __forceinline__ void t_qkn(Frame& F) {
    unsigned char* ws = F.ws;
    bf16* QKV = (bf16*)(ws + WS_QKV); const bf16* Z = (const bf16*)(ws + WS_Z); bf16* AL = (bf16*)(ws + WS_ALORA);
    const float* qg = F.in[4]; const float* kg = F.in[5]; const float* mix = F.in[8];
    const int gw = F.vcu * NWAVES + F.wave, NGW = F.G * NWAVES, lane = F.lane;
    for (int m = gw; m < M; m += NGW) {
#pragma unroll
        for (int ps = 0; ps < 6; ++ps) { const int col = ps * 512 + lane * 8; v4u* p = (v4u*)(QKV + (size_t)m * NQKV + col); const v4u w = *p;
            float v[8] = {blo(w.x), bhi(w.x), blo(w.y), bhi(w.y), blo(w.z), bhi(w.z), blo(w.w), bhi(w.w)}; float ss = 0.f;
#pragma unroll
            for (int j = 0; j < 8; ++j) ss += v[j] * v[j];
            ss += __shfl_xor(ss, 1); ss += __shfl_xor(ss, 2); ss += __shfl_xor(ss, 4); ss += __shfl_xor(ss, 8);
            const float rs = 1.0f / sqrtf(ss * (1.0f / 128.0f) + 1e-6f); const float* g = (col < 1536 ? qg : kg) + (col & 127);
#pragma unroll
            for (int j = 0; j < 8; ++j) v[j] = v[j] * rs * g[j];
            v4u o; o.x = pk2(v[0], v[1]); o.y = pk2(v[2], v[3]); o.z = pk2(v[4], v[5]); o.w = pk2(v[6], v[7]); *p = o; }
        {
            v4u o = (v4u){0u, 0u, 0u, 0u};
            if (lane < 56) { const int c = lane * 8; const v4u w = *(const v4u*)(Z + (size_t)m * NZP + 6144 + c); v4u wp = (v4u){0u, 0u, 0u, 0u};
                if ((m & (SEQ - 1)) != 0) wp = *(const v4u*)(Z + (size_t)(m - 1) * NZP + 6144 + c);
                float v[8] = {blo(w.x), bhi(w.x), blo(w.y), bhi(w.y), blo(w.z), bhi(w.z), blo(w.w), bhi(w.w)};
                const float vp[8] = {blo(wp.x), bhi(wp.x), blo(wp.y), bhi(wp.y), blo(wp.z), bhi(wp.z), blo(wp.w), bhi(wp.w)};
#pragma unroll
                for (int j = 0; j < 8; ++j) { float z = v[j] + mix[6144 + c + j] * (vp[j] - v[j]);
                    if (c < 96) z = tanhf(z); else if (c >= 192) z = 1.0f / (1.0f + __expf(-z));
                    v[j] = z; }
                o.x = pk2(v[0], v[1]); o.y = pk2(v[2], v[3]); o.z = pk2(v[4], v[5]); o.w = pk2(v[6], v[7]); }
            *(v4u*)(AL + (size_t)m * LORAK + lane * 8) = o; }
    }
    transpose_matrix(F, F.in[22], D, DFF, (bf16*)(ws + WS_WMLPIN), F.in[21], 1 << 30, 0);
}

__device__ __forceinline__ float t5_bias_bucket(int dist) {
    if (dist < 16) return (float)dist;
    int l = 16 + (int)(logf((float)dist / 16.0f) / 4.852030263919617f * 16.0f); return (float)(l < 31 ? l : 31);
}
__device__ __forceinline__ void t_attn(Frame& F) {
    unsigned char* ws = F.ws;
    const bf16* QKV = (const bf16*)(ws + WS_QKV); bf16* ATT = (bf16*)(ws + WS_ATT); const float* relb = F.in[6];
    LAS float* btab = (LAS float*)(F.lds + RING_OFF);
    for (int i = F.tid; i < 12 * 136; i += 512) { const int gh = i / 136, j = i % 136, g = gh >> 2, hg = gh & 3; float b = 0.f;
        if (j <= 128) { const int bk = (int)t5_bias_bucket(j << (2 * g)); b = relb[bk * 12 + g * 4 + hg]; }
        btab[i] = b; }
    __syncthreads();
    const int gw = F.vcu * NWAVES + F.wave, NGW = F.G * NWAVES, lane = F.lane;
    const float SC = 0.08838834764831845f;
    for (int it = gw; it < M * 4; it += NGW) {
        const int m = it >> 2, hg = it & 3, t = m & (SEQ - 1);
        float mx = -1e30f, l = 0.f, o0 = 0.f, o1 = 0.f;
        for (int g = 0; g < 3; ++g) {
            const int d = 1 << (2 * g), h = 4 * g + hg;
            const unsigned qw = *(const unsigned*)(QKV + (size_t)m * NQKV + h * 128 + 2 * lane);
            const float q0 = blo(qw) * SC, q1 = bhi(qw) * SC;
            int nk = t / d; nk = (nk > 128 ? 128 : nk) + 1;
            const LAS float* bt = btab + (g * 4 + hg) * 136;
            for (int j0 = 0; j0 < nk; j0 += 8) {
                unsigned kw[8], vw[8];
#pragma unroll
                for (int u = 0; u < 8; ++u) { int jj = j0 + u; jj = jj < nk ? jj : nk - 1; const bf16* rp = QKV + (size_t)(m - jj * d) * NQKV + h * 128 + 2 * lane;
                    kw[u] = *(const unsigned*)(rp + 1536); vw[u] = *(const unsigned*)(rp + 3072); }
                float s[8];
#pragma unroll
                for (int u = 0; u < 8; ++u) s[u] = wave_sum(q0 * blo(kw[u]) + q1 * bhi(kw[u]));
#pragma unroll
                for (int u = 0; u < 8; ++u) { const int j = j0 + u; const float sv = j < nk ? s[u] + bt[j] : -1e30f;
                    const float mn = fmaxf(mx, sv), c = __expf(mx - mn), p = __expf(sv - mn);
                    l = l * c + p; o0 = o0 * c + p * blo(vw[u]); o1 = o1 * c + p * bhi(vw[u]); mx = mn; }
            }
        }
        const float inv = 1.0f / l;
        *(unsigned*)(ATT + (size_t)m * AOW + hg * 128 + 2 * lane) = pk2(o0 * inv, o1 * inv);
    }
}

__device__ __forceinline__ void t_scan(Frame& F) {
    unsigned char* ws = F.ws;
    const bf16* Z = (const bf16*)(ws + WS_Z); const bf16* EAG = (const bf16*)(ws + WS_EAG); bf16* RW = (bf16*)(ws + WS_RW);
    const float* mix = F.in[8]; const float* k_k = F.in[14]; const float* k_a = F.in[15]; const float* r_k = F.in[16]; const float* gn_w = F.in[17]; const float* gn_b = F.in[18];
    constexpr int TB = 32;
    LAS float* IN = (LAS float*)(F.lds + RING_OFF);
    LAS float* VV = IN + TB * 320;
    LAS float* YY = VV + TB * 64;
    LAS float* RK = YY + TB * 64;
    const int lane = F.lane, wave = F.wave;
    for (int unit = blockIdx.x; unit < 128; unit += F.G) {
        const int b = unit >> 5, h = unit & 31, c = h * 64 + lane;
        const float mr = mix[c], mk = mix[2048 + c], mv = mix[4096 + c], kkc = k_k[c], kac = k_a[c], rkc = r_k[c], gw_ = gn_w[c], gb_ = gn_b[c];
        float S[64];
#pragma unroll
        for (int j = 0; j < 64; ++j) S[j] = 0.f;
        for (int blk = 0; blk < SEQ / TB; ++blk) {
#pragma unroll 1
            for (int q = 0; q < TB / 8; ++q) { const int s = wave + 8 * q, t = blk * TB + s; const size_t row = (size_t)b * SEQ + t; const bf16* zr = Z + row * NZP;
                float r = bf1(zr[c]), k = bf1(zr[2048 + c]), v = bf1(zr[4096 + c]), rp = 0.f, kp_ = 0.f, vp = 0.f;
                if (t > 0) { rp = bf1(zr[c - NZP]); kp_ = bf1(zr[2048 + c - NZP]); vp = bf1(zr[4096 + c - NZP]); }
                r = r + mr * (rp - r); k = k + mk * (kp_ - k); v = v + mv * (vp - v);
                const float e = bf1(EAG[row * 2048 + c]), a = bf1(EAG[(size_t)M * 2048 + row * 2048 + c]);
                const float decay = __expf(-e);
                const float kkj = k * kkc, n2 = wave_sum(kkj * kkj), kk = kkj / fmaxf(sqrtf(n2), 1e-12f);
                const float kp = k * (1.0f + (a - 1.0f) * kac);
                const float rks = wave_sum(r * kp * rkc);
                LAS float* o = IN + s * 320 + lane;
                o[0] = -kk; o[64] = decay; o[128] = kk * a; o[192] = kp; o[256] = r; VV[s * 64 + lane] = v; if (lane == 0) RK[s] = rks; }
            __syncthreads();
            if (wave == 0) {
#pragma unroll 1
                for (int s = 0; s < TB; ++s) {
                    const LAS f32x4* A4 = (const LAS f32x4*)(IN + s * 320);
                    float sa = 0.f;
#pragma unroll
                    for (int j = 0; j < 16; ++j) { const f32x4 a = A4[j]; sa += S[4 * j] * a.x + S[4 * j + 1] * a.y + S[4 * j + 2] * a.z + S[4 * j + 3] * a.w; }
                    const float vi = VV[s * 64 + lane]; float y = 0.f;
#pragma unroll
                    for (int j = 0; j < 16; ++j) { const f32x4 w = A4[16 + j], bb = A4[32 + j], kq = A4[48 + j], rr = A4[64 + j];
                        S[4 * j] = S[4 * j] * w.x + sa * bb.x + vi * kq.x; y += S[4 * j] * rr.x;
                        S[4 * j + 1] = S[4 * j + 1] * w.y + sa * bb.y + vi * kq.y; y += S[4 * j + 1] * rr.y;
                        S[4 * j + 2] = S[4 * j + 2] * w.z + sa * bb.z + vi * kq.z; y += S[4 * j + 2] * rr.z;
                        S[4 * j + 3] = S[4 * j + 3] * w.w + sa * bb.w + vi * kq.w; y += S[4 * j + 3] * rr.w; }
                    YY[s * 64 + lane] = y;
                }
            }
            __syncthreads();
#pragma unroll 1
            for (int q = 0; q < TB / 8; ++q) { const int s = wave + 8 * q, t = blk * TB + s; const size_t row = (size_t)b * SEQ + t;
                const float y = YY[s * 64 + lane], mu = wave_sum(y) * (1.0f / 64.0f), dy = y - mu, var = wave_sum(dy * dy) * (1.0f / 64.0f);
                float yn = dy * (1.0f / sqrtf(var + 64e-5f)) * gw_ + gb_;
                yn += RK[s] * VV[s * 64 + lane];
                const float g = bf1(EAG[(size_t)2 * M * 2048 + row * 2048 + c]);
                RW[row * 2048 + c] = (bf16)f2bf(yn * g); }
            __syncthreads();
        }
    }
}

struct Args { const float* in[27]; float* out; unsigned char* ws; int ph_lo, ph_hi; };
__global__ void __launch_bounds__(NWAVES * 64, 2) mk_fwd(Args args) {
    extern __shared__ __attribute__((aligned(16))) unsigned char lds[];
    Frame F;
    F.lds = (LAS unsigned char*)lds;
    F.MISC = (volatile LAS unsigned*)(F.lds + MISC_OFF);
    F.tid = threadIdx.x; F.lane = F.tid & 63; F.wave = __builtin_amdgcn_readfirstlane(F.tid >> 6);
    F.G = gridDim.x; { const int bx = blockIdx.x; F.vcu = (F.G % 8 == 0) ? (bx % 8) * (F.G / 8) + bx / 8 : bx; }
#pragma unroll
    for (int i = 0; i < 27; ++i) F.in[i] = args.in[i];
    F.out = args.out; F.ws = args.ws; unsigned char* ws = args.ws;
    F.ctl = (gu32*)(ws + WS_CTL);
    for (int u = F.tid; u < (LDS_BYTES - LDSCTL_OFF) / 4; u += NWAVES * 64) ((LAS unsigned*)(F.lds + LDSCTL_OFF))[u] = 0u;
    __syncthreads();
    const int lo = args.ph_lo, hi = args.ph_hi;
#if MK_ONE_LAUNCH
    XcdBarrier bar = xcd_barrier_post((unsigned*)(F.ctl + CW_BAR), F.MISC + 8);
#define GRID_BAR() xcd_barrier(bar)
#else
#define GRID_BAR() do {} while (0)
#endif
#define IN(k) (lo <= (k) && (k) < hi)
#define BOTH(k) (IN(k) && IN((k) + 1))
    bf16* XB = (bf16*)(ws + WS_XB); float* RSTD = (float*)(ws + WS_RSTD);
    const int bx = (int)blockIdx.x;

    if (IN(P_PRO)) { p_prologue(F); if (BOTH(P_PRO)) GRID_BAR(); }
    if (IN(G_WIN)) {
        pg8::Gemm g{XB, (const bf16*)(ws + WS_WIN), M, NINP, D, D, D}; pg8::StaticOrder S; S.init(M, NINP, F.G, bx);
        pg8::EpiWin E{(bf16*)(ws + WS_QKV), (bf16*)(ws + WS_Z), (bf16*)(ws + WS_GT), RSTD};
        pg8::gemm_phase<pg8::EpiWin, pg8::StaticOrder, true, true>(F.lds + RING_OFF, g, S, E);
        if (BOTH(G_WIN)) GRID_BAR();
    }
    if (IN(T_QKN)) { t_qkn(F); if (BOTH(T_QKN)) GRID_BAR(); }
    if (IN(G_LORA)) {
        pg8::Gemm g{(const bf16*)(ws + WS_ALORA), (const bf16*)(ws + WS_WLORA), M, LORAN, LORAK, LORAK, LORAK}; pg8::StaticOrder S; S.init(M, LORAN, F.G, bx);
        pg8::EpiLora E{(bf16*)(ws + WS_EAG), F.in[9], F.in[11], (size_t)M * 2048};
        pg8::gemm_phase<pg8::EpiLora, pg8::StaticOrder, true, true>(F.lds + RING_OFF, g, S, E);
        if (BOTH(G_LORA)) GRID_BAR();
    }
    if (IN(T_ATTN)) { t_attn(F); if (BOTH(T_ATTN)) GRID_BAR(); }
    if (IN(T_SCAN)) { t_scan(F); if (BOTH(T_SCAN)) GRID_BAR(); }
    if (IN(G_ATTUP)) {
        pg8::Gemm g{(const bf16*)(ws + WS_ATT), (const bf16*)(ws + WS_WATT), M, D, AOW, AOW, AOW}; pg8::StaticOrder S; S.init(M, D, F.G, bx);
        pg8::EpiB<2> E{(bf16*)(ws + WS_AD), D, nullptr, (const bf16*)(ws + WS_GT), nullptr};
        pg8::gemm_phase<pg8::EpiB<2>, pg8::StaticOrder, true, true>(F.lds + RING_OFF, g, S, E);
        if (BOTH(G_ATTUP)) GRID_BAR();
    }
    if (IN(G_RWUP)) {
        pg8::Gemm g{(const bf16*)(ws + WS_RW), (const bf16*)(ws + WS_WRW), M, D, RWW, RWW, RWW}; pg8::StaticOrder S; S.init(M, D, F.G, bx);
        pg8::EpiB<3> E{(bf16*)(ws + WS_MERGED), D, nullptr, (const bf16*)(ws + WS_GT), (const bf16*)(ws + WS_AD)};
        pg8::gemm_phase<pg8::EpiB<3>, pg8::StaticOrder, true, true>(F.lds + RING_OFF, g, S, E);
        if (BOTH(G_RWUP)) GRID_BAR();
    }
    if (IN(G_OUT)) {
        pg8::Gemm g{(const bf16*)(ws + WS_MERGED), (const bf16*)(ws + WS_WOUT), M, D, D, D, D}; pg8::StaticOrder S; S.init(M, D, F.G, bx);
        pg8::EpiF<0> E{F.in[0], F.out, nullptr, nullptr};
        pg8::gemm_phase<pg8::EpiF<0>, pg8::StaticOrder, true, true>(F.lds + RING_OFF, g, S, E);
        if (BOTH(G_OUT)) GRID_BAR();
    }
    if (IN(T_N2)) {
        rows_to_bf16_rstd(F, F.out, XB, RSTD + M);
        transpose_matrix(F, F.in[23], DFF, D, (bf16*)(ws + WS_WMLPOUT), nullptr, 1 << 30, 0);
        transpose_matrix(F, F.in[25], D, D, (bf16*)(ws + WS_WPLEG), F.in[24], 1 << 30, 0);
        transpose_matrix(F, F.in[26], PLE, D, (bf16*)(ws + WS_WPLEP), nullptr, 1 << 30, 0);
        if (BOTH(T_N2)) GRID_BAR();
    }
    if (IN(G_MLPIN)) {
        pg8::Gemm g{XB, (const bf16*)(ws + WS_WMLPIN), M, DFF, D, D, D}; pg8::StaticOrder S; S.init(M, DFF, F.G, bx);
        pg8::EpiB<1> E{(bf16*)(ws + WS_HID), DFF, RSTD + M, nullptr, nullptr};
        pg8::gemm_phase<pg8::EpiB<1>, pg8::StaticOrder, true, true>(F.lds + RING_OFF, g, S, E);
        if (BOTH(G_MLPIN)) GRID_BAR();
    }
    if (IN(G_MLPOUT)) {
        pg8::Gemm g{(const bf16*)(ws + WS_HID), (const bf16*)(ws + WS_WMLPOUT), M, D, DFF, DFF, DFF}; pg8::StaticOrder S; S.init(M, D, F.G, bx);
        pg8::EpiF<0> E{F.out, F.out, nullptr, nullptr};
        pg8::gemm_phase<pg8::EpiF<0>, pg8::StaticOrder, true, true>(F.lds + RING_OFF, g, S, E);
        if (BOTH(G_MLPOUT)) GRID_BAR();
    }
    if (IN(T_N3)) { rows_to_bf16_rstd(F, F.out, XB, RSTD + 2 * M); if (BOTH(T_N3)) GRID_BAR(); }
    if (IN(G_PP)) {
        pg8::Gemm g{(const bf16*)(ws + WS_PB), (const bf16*)(ws + WS_WPLEP), M, D, PLE, PLE, PLE}; pg8::StaticOrder S; S.init(M, D, F.G, bx);
        pg8::EpiB<0> E{(bf16*)(ws + WS_PP), D, nullptr, nullptr, nullptr};
        pg8::gemm_phase<pg8::EpiB<0>, pg8::StaticOrder, true, true>(F.lds + RING_OFF, g, S, E);
        if (BOTH(G_PP)) GRID_BAR();
    }
    if (IN(G_PLE)) {
        pg8::Gemm g{XB, (const bf16*)(ws + WS_WPLEG), M, D, D, D, D}; pg8::StaticOrder S; S.init(M, D, F.G, bx);
        pg8::EpiF<1> E{F.out, F.out, RSTD + 2 * M, (const bf16*)(ws + WS_PP)};
        pg8::gemm_phase<pg8::EpiF<1>, pg8::StaticOrder, true, true>(F.lds + RING_OFF, g, S, E);
    }
#undef IN
#undef BOTH
}

extern "C" void kernel_launch(void* const* d_in, const int* in_sizes, int n_in, void* d_out, int out_size, void* d_ws, size_t ws_size, hipStream_t stream) {
    static int grid = 0;
    if (grid == 0) {
        if (n_in != 27 || in_sizes[0] != M * D || out_size != M * D || ws_size < WS_END) { fprintf(stderr, "kernel_launch: unexpected shapes: n_in %d in0 %d out %d ws %zu (need %zu)\n", n_in, n_in > 0 ? in_sizes[0] : -1, out_size, ws_size, (size_t)WS_END); grid = -1; return; }
        int dev = 0, cus = 0, per_cu = 0;
        if (hipGetDevice(&dev) != hipSuccess || hipDeviceGetAttribute(&cus, hipDeviceAttributeMultiprocessorCount, dev) != hipSuccess) { grid = -1; return; }
        if (hipFuncSetAttribute((const void*)mk_fwd, hipFuncAttributeMaxDynamicSharedMemorySize, LDS_BYTES) != hipSuccess) { fprintf(stderr, "kernel_launch: hipFuncSetAttribute failed\n"); grid = -1; return; }
        if (hipOccupancyMaxActiveBlocksPerMultiprocessor(&per_cu, (const void*)mk_fwd, NWAVES * 64, LDS_BYTES) != hipSuccess || per_cu < 1)
            fprintf(stderr, "kernel_launch: note: occupancy query reports %d workgroups per CU\n", per_cu);
        (void)hipGetLastError();
        grid = cus;
    }
    if (grid < 0) return;
    if (hipMemsetAsync((char*)d_ws + WS_CTL, 0, CTL_ZERO_BYTES, stream) != hipSuccess) return;
    Args a{};
    for (int i = 0; i < 27; ++i) a.in[i] = (const float*)d_in[i];
    a.out = (float*)d_out; a.ws = (unsigned char*)d_ws;
#if MK_ONE_LAUNCH
    a.ph_lo = 0; a.ph_hi = NPH;
    hipLaunchKernelGGL(mk_fwd, dim3(grid), dim3(NWAVES * 64), LDS_BYTES, stream, a);
#else
    for (int ph = 0; ph < NPH; ++ph) { a.ph_lo = ph; a.ph_hi = ph + 1; hipLaunchKernelGGL(mk_fwd, dim3(grid), dim3(NWAVES * 64), LDS_BYTES, stream, a); }
#endif
}
```

```cpp
#include <hip/hip_runtime.h>
#include <cstdio>
#include <cstdint>
namespace pg8 {
#define PG8_LAS __attribute__((address_space(3)))
typedef unsigned short bf16_t;
typedef short bf16x8 __attribute__((ext_vector_type(8)));
typedef float f32x4 __attribute__((ext_vector_type(4)));
typedef unsigned u32x4 __attribute__((ext_vector_type(4)));
typedef unsigned u32x2 __attribute__((ext_vector_type(2)));
constexpr int BM = 256, BK = 64, HALF = 128, HTB = HALF * BK * 2  , STAGE_BYTES = 8 * HTB, NXCD = 8, WGM = 8;

__host__ __device__ __forceinline__ int lds_byte(int r, int c) { const int st = (r >> 4) * 2 + (c >> 5), rr = r & 15, cc = c & 31, ob = rr * 64 + cc * 2; return st * 1024 + (ob ^ (((ob >> 9) & 1) << 5)); }
__host__ __device__ __forceinline__ void stage_rc(int b, int& R, int& C) { const int st = b / 1024, sb = b % 1024, swz = sb ^ (((sb >> 9) & 1) << 5); R = (st >> 1) * 16 + swz / 64; C = (st & 1) * 32 + (swz % 64) / 2; }
__host__ __device__ __forceinline__ int perm32(int rho) { const int n = rho >> 4, i = rho & 15; return 8 * (i >> 2) + 4 * n + (i & 3); }

struct Unit { int pm, pn; };
struct Gemm { const bf16_t* A; const bf16_t* Bt; int M, N, K, lda, ldb, kmode; };

struct StaticOrder {
    int nM, nN, nwg, G, c;
    __host__ __device__ void init(int M, int N, int G_, int c_) { nM = M / BM; nN = N / BM; nwg = nM * nN; G = G_; c = c_; }
    __host__ __device__ bool next(int i, Unit& u) const {
        const long L = (long)i * G + c; if (L >= nwg) return false;
        int wgid = (int)L; { const int q = nwg / NXCD, r = nwg % NXCD, xcd = wgid % NXCD, off = wgid / NXCD; wgid = (xcd < r ? xcd * (q + 1) : r * (q + 1) + (xcd - r) * q) + off; }
        const int nig = WGM * nN, gid = wgid / nig, fm = gid * WGM, gsz = (nM - fm) < WGM ? (nM - fm) : WGM;
        u.pm = fm + ((wgid % nig) % gsz); u.pn = (wgid % nig) / gsz; return true;
    }
    __device__ __forceinline__ void a_ready(const Unit&) const {}
    __device__ __forceinline__ void done(const Unit&) const {}
};
typedef float cvt_f2 __attribute__((ext_vector_type(2)));
typedef __bf16 cvt_b2 __attribute__((ext_vector_type(2)));
__device__ __forceinline__ unsigned cvt_pk_bf16_n(float lo, float hi) { const cvt_f2 x = {lo, hi}; return __builtin_bit_cast(unsigned, __builtin_convertvector(x, cvt_b2)); }
__device__ __forceinline__ unsigned cvt_pk_bf16(float lo, float hi) { unsigned r; asm volatile("s_nop 0\n\tv_cvt_pk_bf16_f32 %0, %1, %2" : "=v"(r) : "v"(lo), "v"(hi)); return r; }
typedef int i32x4 __attribute__((ext_vector_type(4)));
template <bool I8> struct AccT { typedef f32x4 type; };
template <> struct AccT<true> { typedef i32x4 type; };
template <bool I8> __device__ __forceinline__ typename AccT<I8>::type mma_(const bf16x8 a, const bf16x8 b, const typename AccT<I8>::type c) {
    if constexpr (I8) return __builtin_amdgcn_mfma_i32_16x16x64_i8(__builtin_bit_cast(i32x4, a), __builtin_bit_cast(i32x4, b), c, 0, 0, 0);
    else return __builtin_amdgcn_mfma_f32_16x16x32_bf16(a, b, c, 0, 0, 0);
}
__device__ __forceinline__ float bf_lo(unsigned w) { return __builtin_bit_cast(float, w << 16); }
__device__ __forceinline__ float bf_hi(unsigned w) { return __builtin_bit_cast(float, w & 0xffff0000u); }
__device__ __forceinline__ float sigmoidf_(float x) { return __builtin_amdgcn_rcpf(1.0f + __builtin_amdgcn_exp2f(-1.4426950408889634f * x)); }

template <class Epi, class Sched, bool ALIGN_EPI = false, bool SP2 = false, bool I8 = false>
__device__ __forceinline__ void gemm_phase(PG8_LAS unsigned char* lds, const Gemm g, const Sched& S, const Epi& E) {
    const int tid = threadIdx.x, wid = __builtin_amdgcn_readfirstlane(tid >> 6), lane = tid & 63, wr = wid >> 2, wc = wid & 3, fr = lane & 15, fq = lane >> 4;
    const int K = g.K;
#define PG8_K0B(u) (g.kmode ? (((u).pn >> 3) == 0 ? 0 : (((u).pn >> 3) == 1 ? 128 : 384)) : 0)
#define PG8_NT(u) (g.kmode ? (((u).pn >> 3) == 2 ? 4 : 2) : K / BK)
    unsigned voffA[2], voffB[2];
#pragma unroll
    for (int i = 0; i < 2; ++i) { int R, C; stage_rc(tid * 16 + i * 8192, R, C); const int Rb = Epi::PERM ? ((R & ~31) + perm32(R & 31)) : R;
        voffA[i] = (unsigned)(R * g.lda + C) * 2u; voffB[i] = (unsigned)(Rb * g.ldb + C) * 2u; }
    const size_t kstep = (size_t)(BK * 2);
    const size_t hstepA = (size_t)HALF * g.lda * 2, hstepB = (size_t)HALF * g.ldb * 2;
    const size_t tstepA = 2 * hstepA, tstepB = 2 * hstepB;
    const unsigned ldsw = (unsigned)wid * 1024u;
    const int aoff = lds_byte(wr * 64 + fr, fq * 8), boff = lds_byte(wc * 32 + fr, fq * 8);
#define PG8_SA(b, h) (((b) * 2 + (h)) * HTB)
#define PG8_SB(b, h) ((4 + (b) * 2 + (h)) * HTB)
#define PG8_STAGE(bufoff, gbase, voff) do { _Pragma("unroll") for (int _i = 0; _i < 2; ++_i) \
        __builtin_amdgcn_global_load_lds((const unsigned*)((const char*)(gbase) + (voff)[_i]), (PG8_LAS unsigned*)(lds + (bufoff) + ldsw + _i * 8192), 16, 0, 0); } while (0)
#define PG8_LDA(dst, b, h) do { _Pragma("unroll") for (int m = 0; m < 4; ++m) _Pragma("unroll") for (int k = 0; k < 2; ++k) dst[m][k] = *(const PG8_LAS bf16x8*)(lds + PG8_SA(b, h) + aoff + m * 2048 + k * 1024); } while (0)
#define PG8_LDB(dst, b, h) do { _Pragma("unroll") for (int n = 0; n < 2; ++n) _Pragma("unroll") for (int k = 0; k < 2; ++k) dst[n][k] = *(const PG8_LAS bf16x8*)(lds + PG8_SB(b, h) + boff + n * 2048 + k * 1024); } while (0)
#define PG8_MMA(ai, bj, At, Bt) do { __builtin_amdgcn_s_setprio(1); _Pragma("unroll") for (int m = 0; m < 4; ++m) _Pragma("unroll") for (int n = 0; n < 2; ++n) _Pragma("unroll") for (int k = 0; k < 2; ++k) \
        acc[ai][bj][m][n] = mma_<I8>(Bt[n][k], At[m][k], acc[ai][bj][m][n]); __builtin_amdgcn_s_setprio(0); } while (0)
#define PG8_WAIT_V(n) asm volatile("s_waitcnt vmcnt(" #n ")" ::: "memory")
#define PG8_WAIT_L(n) asm volatile("s_waitcnt lgkmcnt(" #n ")" ::: "memory")
#define PG8_BAR __builtin_amdgcn_s_barrier()
#define PG8_SCHED __builtin_amdgcn_sched_barrier(0)
    Unit cur, nxt; int ui = 0;
    if (!S.next(0, cur)) return;
    typename AccT<I8>::type acc[2][2][4][2];
#pragma unroll
    for (int a = 0; a < 2; ++a)
#pragma unroll
        for (int b = 0; b < 2; ++b)
#pragma unroll
            for (int m = 0; m < 4; ++m)
#pragma unroll
                for (int n = 0; n < 2; ++n) acc[a][b][m][n] = (typename AccT<I8>::type){0, 0, 0, 0};
    bf16x8 At[4][2], B0[2][2], B1[2][2];
    const char* cA = (const char*)g.A + (size_t)cur.pm * tstepA + PG8_K0B(cur); const char* cB = (const char*)g.Bt + (size_t)cur.pn * tstepB + PG8_K0B(cur);
    int nt = PG8_NT(cur);
    S.a_ready(cur);
    if constexpr (SP2) {
        PG8_STAGE(PG8_SB(0, 0), cB, voffB); PG8_STAGE(PG8_SB(0, 1), cB + hstepB, voffB); PG8_STAGE(PG8_SA(0, 0), cA, voffA); PG8_STAGE(PG8_SA(0, 1), cA + hstepA, voffA);
        if (wr == 1) PG8_BAR;
        PG8_WAIT_V(2); PG8_BAR;
        PG8_STAGE(PG8_SB(1, 0), cB + kstep, voffB); PG8_STAGE(PG8_SA(1, 0), cA + kstep, voffA); PG8_STAGE(PG8_SB(1, 1), cB + hstepB + kstep, voffB);
        PG8_WAIT_V(6); PG8_BAR;
    } else {
        PG8_STAGE(PG8_SB(0, 0), cB, voffB); PG8_STAGE(PG8_SA(0, 0), cA, voffA); PG8_STAGE(PG8_SB(0, 1), cB + hstepB, voffB); PG8_STAGE(PG8_SA(0, 1), cA + hstepA, voffA);
        if (wr == 1) PG8_BAR;
        PG8_WAIT_V(4); PG8_BAR;
        PG8_STAGE(PG8_SB(1, 0), cB + kstep, voffB); PG8_STAGE(PG8_SA(1, 0), cA + kstep, voffA); PG8_STAGE(PG8_SB(1, 1), cB + hstepB + kstep, voffB);
        PG8_WAIT_V(6); PG8_BAR;
    }
    for (;;) {
        const bool has_next = S.next(ui + 1, nxt);
        const char* nA = has_next ? (const char*)g.A + (size_t)nxt.pm * tstepA + PG8_K0B(nxt) : cA; const char* nB = has_next ? (const char*)g.Bt + (size_t)nxt.pn * tstepB + PG8_K0B(nxt) : cB;
        for (int t = 0; t < nt; t += 2) {
            const bool last = (t == nt - 2);
            const char* a1 = cA + (size_t)(t + 1) * kstep;
            const char* a2 = last ? nA : cA + (size_t)(t + 2) * kstep; const char* b2 = last ? nB : cB + (size_t)(t + 2) * kstep;
            const char* a3 = a2 + kstep; const char* b3 = b2 + kstep;
            if (last && has_next) S.a_ready(nxt);
            if constexpr (SP2) {
            PG8_LDB(B0, 0, 0); PG8_LDB(B1, 0, 1); PG8_SCHED; PG8_LDA(At, 0, 0); PG8_STAGE(PG8_SA(1, 1), a1 + hstepA, voffA);
            PG8_WAIT_V(8); PG8_WAIT_L(0); PG8_BAR; PG8_MMA(0, 0, At, B0); PG8_MMA(0, 1, At, B1); PG8_BAR; PG8_SCHED;
            PG8_LDA(At, 0, 1); PG8_STAGE(PG8_SB(0, 0), b2, voffB); PG8_STAGE(PG8_SB(0, 1), b2 + hstepB, voffB); PG8_STAGE(PG8_SA(0, 0), a2, voffA);
            PG8_WAIT_V(8); PG8_WAIT_L(0); PG8_BAR; PG8_MMA(1, 0, At, B0); PG8_MMA(1, 1, At, B1); PG8_BAR; PG8_SCHED;
            PG8_LDB(B0, 1, 0); PG8_LDB(B1, 1, 1); PG8_SCHED; PG8_LDA(At, 1, 0); PG8_STAGE(PG8_SA(0, 1), a2 + hstepA, voffA);
            PG8_WAIT_V(8); PG8_WAIT_L(0); PG8_BAR; PG8_MMA(0, 0, At, B0); PG8_MMA(0, 1, At, B1); PG8_BAR; PG8_SCHED;
            PG8_LDA(At, 1, 1); PG8_STAGE(PG8_SB(1, 0), b3, voffB); PG8_STAGE(PG8_SB(1, 1), b3 + hstepB, voffB); PG8_STAGE(PG8_SA(1, 0), a3, voffA);
            PG8_WAIT_V(8); PG8_WAIT_L(0); PG8_BAR; PG8_MMA(1, 0, At, B0); PG8_MMA(1, 1, At, B1); PG8_BAR; PG8_SCHED;
            } else {
            PG8_LDB(B0, 0, 0); PG8_SCHED; PG8_LDA(At, 0, 0); PG8_STAGE(PG8_SA(1, 1), a1 + hstepA, voffA);
            PG8_WAIT_L(8); PG8_BAR; PG8_WAIT_L(0); PG8_MMA(0, 0, At, B0); PG8_BAR; PG8_SCHED;
            PG8_LDB(B1, 0, 1); PG8_STAGE(PG8_SB(0, 0), b2, voffB);
            PG8_BAR; PG8_WAIT_L(0); PG8_MMA(0, 1, At, B1); PG8_BAR;
            PG8_LDA(At, 0, 1); PG8_STAGE(PG8_SA(0, 0), a2, voffA);
            PG8_BAR; PG8_WAIT_L(0); PG8_MMA(1, 0, At, B0); PG8_BAR; PG8_SCHED;
            PG8_STAGE(PG8_SB(0, 1), b2 + hstepB, voffB);
            PG8_WAIT_V(6); PG8_BAR; PG8_MMA(1, 1, At, B1); PG8_BAR;
            PG8_LDB(B0, 1, 0); PG8_SCHED; PG8_LDA(At, 1, 0); PG8_STAGE(PG8_SA(0, 1), a2 + hstepA, voffA);
            PG8_WAIT_L(8); PG8_BAR; PG8_WAIT_L(0); PG8_MMA(0, 0, At, B0); PG8_BAR; PG8_SCHED;
            PG8_LDB(B1, 1, 1); PG8_STAGE(PG8_SB(1, 0), b3, voffB);
            PG8_BAR; PG8_WAIT_L(0); PG8_MMA(0, 1, At, B1); PG8_BAR;
            PG8_LDA(At, 1, 1); PG8_STAGE(PG8_SA(1, 0), a3, voffA);
            PG8_BAR; PG8_WAIT_L(0); PG8_MMA(1, 0, At, B0); PG8_BAR; PG8_SCHED;
            PG8_STAGE(PG8_SB(1, 1), b3 + hstepB, voffB);
            PG8_WAIT_V(6); PG8_BAR; PG8_MMA(1, 1, At, B1); PG8_BAR;
            }
        }
        if constexpr (ALIGN_EPI) { if (wr == 0) PG8_BAR; }
        if constexpr (!Epi::AFTER_DRAIN) { int t2 = threadIdx.x; asm volatile("" : "+v"(t2)); const int w2 = t2 >> 6, l2 = t2 & 63; E(acc, cur, w2 >> 2, w2 & 3, l2 & 15, l2 >> 4); S.done(cur); }
        if (!has_next) break;
#pragma unroll
        for (int a = 0; a < 2; ++a)
#pragma unroll
            for (int b = 0; b < 2; ++b)
#pragma unroll
                for (int m = 0; m < 4; ++m)
#pragma unroll
                    for (int n = 0; n < 2; ++n) acc[a][b][m][n] = (typename AccT<I8>::type){0, 0, 0, 0};
        cur = nxt; cA = nA; cB = nB; ++ui; nt = PG8_NT(cur);
        if constexpr (ALIGN_EPI) { if (wr == 1) PG8_BAR; }
    }
    PG8_WAIT_V(0);
    if constexpr (!ALIGN_EPI) { if (wr == 0) PG8_BAR; }
    PG8_BAR;
    if constexpr (Epi::AFTER_DRAIN) { E.fused(acc, cur, wr, wc, fr, fq, lds, wid, lane); S.done(cur); }
#undef PG8_SA
#undef PG8_SB
#undef PG8_STAGE
#undef PG8_LDA
#undef PG8_LDB
#undef PG8_MMA
#undef PG8_WAIT_V
#undef PG8_WAIT_L
#undef PG8_BAR
#undef PG8_SCHED
#undef PG8_K0B
#undef PG8_NT
}

typedef const f32x4 (&AccRef)[2][2][4][2];
__device__ __forceinline__ u32x4 pack8(const f32x4 v0, const f32x4 v1) { u32x4 w; w.x = cvt_pk_bf16(v0[0], v0[1]); w.y = cvt_pk_bf16(v0[2], v0[3]); w.z = cvt_pk_bf16(v1[0], v1[1]); w.w = cvt_pk_bf16(v1[2], v1[3]); return w; }
__device__ __forceinline__ void unpack8(const u32x4 w, f32x4& v0, f32x4& v1) { v0 = (f32x4){bf_lo(w.x), bf_hi(w.x), bf_lo(w.y), bf_hi(w.y)}; v1 = (f32x4){bf_lo(w.z), bf_hi(w.z), bf_lo(w.w), bf_hi(w.w)}; }
__device__ __forceinline__ f32x4 sig4(const f32x4 v) { return (f32x4){sigmoidf_(v[0]), sigmoidf_(v[1]), sigmoidf_(v[2]), sigmoidf_(v[3])}; }

struct EpiWin {
    static constexpr bool PERM = true, AFTER_DRAIN = false;
    bf16_t* QKV; bf16_t* Z; bf16_t* GT; const float* rstd; int pn0;
    __device__ __forceinline__ void operator()(AccRef acc, const Unit& uu, int wr, int wc, int fr, int fq) const {
        Unit u = uu; u.pn += pn0;
        const int row0 = u.pm * BM + wr * 64 + fr;
        bf16_t* base; int ldc, colt; bool sg = false;
        if (u.pn < 18) { base = QKV; ldc = 4608; colt = u.pn * 256; }
        else if (u.pn < 44) { base = Z; ldc = 6656; colt = (u.pn - 18) * 256; }
        else { base = GT; ldc = 8192; colt = (u.pn - 44) * 256; sg = true; }
        const int col0 = colt + wc * 32 + 8 * fq;
        float rsv[2][4];
#pragma unroll
        for (int ai = 0; ai < 2; ++ai)
#pragma unroll
            for (int m = 0; m < 4; ++m) rsv[ai][m] = rstd[row0 + ai * HALF + m * 16];
#pragma unroll
        for (int ai = 0; ai < 2; ++ai)
#pragma unroll
            for (int m = 0; m < 4; ++m) { const int r = row0 + ai * HALF + m * 16; const float rs = rsv[ai][m]; bf16_t* rowp = base + (size_t)r * ldc + col0;
#pragma unroll
                for (int bj = 0; bj < 2; ++bj) { f32x4 v0 = acc[ai][bj][m][0] * rs, v1 = acc[ai][bj][m][1] * rs;
                    if (sg) { v0 = sig4(v0); v1 = sig4(v1); }
                    *(u32x4*)(rowp + bj * HALF) = pack8(v0, v1); } }
    }
};
struct EpiWin8 {
    static constexpr bool PERM = true, AFTER_DRAIN = false;
    bf16_t* QKV; bf16_t* Z; bf16_t* GT; const float* rstd; const float* sx; const float* sw; int pn0;
    __device__ __forceinline__ void operator()(const i32x4 (&acc)[2][2][4][2], const Unit& uu, int wr, int wc, int fr, int fq) const {
        Unit u = uu; u.pn += pn0;
        const int row0 = u.pm * BM + wr * 64 + fr, cl = wc * 32 + 8 * fq;
        bf16_t* base; int ldc, colt; bool sg = false;
        if (u.pn < 18) { base = QKV; ldc = 4608; colt = u.pn * 256; }
        else if (u.pn < 44) { base = Z; ldc = 6656; colt = (u.pn - 18) * 256; }
        else { base = GT; ldc = 8192; colt = (u.pn - 44) * 256; sg = true; }
        const int col0 = colt + cl;
        f32x4 sv[2][2];
#pragma unroll
        for (int bj = 0; bj < 2; ++bj)
#pragma unroll
            for (int n = 0; n < 2; ++n) sv[bj][n] = *(const f32x4*)(sw + u.pn * BM + cl + bj * HALF + 4 * n);
        float rsv[2][4];
#pragma unroll
        for (int ai = 0; ai < 2; ++ai)
#pragma unroll
            for (int m = 0; m < 4; ++m) { const int r = row0 + ai * HALF + m * 16; rsv[ai][m] = rstd[r] * sx[r]; }
#pragma unroll
        for (int ai = 0; ai < 2; ++ai)
#pragma unroll
            for (int m = 0; m < 4; ++m) { const int r = row0 + ai * HALF + m * 16; const float rs = rsv[ai][m]; bf16_t* rowp = base + (size_t)r * ldc + col0;
#pragma unroll
                for (int bj = 0; bj < 2; ++bj) { f32x4 v0 = __builtin_convertvector(acc[ai][bj][m][0], f32x4) * rs * sv[bj][0], v1 = __builtin_convertvector(acc[ai][bj][m][1], f32x4) * rs * sv[bj][1];
                    if (sg) { v0 = sig4(v0); v1 = sig4(v1); }
                    *(u32x4*)(rowp + bj * HALF) = pack8(v0, v1); } }
    }
};
struct EpiMlp8 {
    static constexpr bool PERM = true, AFTER_DRAIN = false;
    bf16_t* O; int ldc; const float* ss; const float* sx; const float* sw;
    __device__ __forceinline__ void operator()(const i32x4 (&acc)[2][2][4][2], const Unit& u, int wr, int wc, int fr, int fq) const {
        const int row0 = u.pm * BM + wr * 64 + fr, col0 = u.pn * BM + wc * 32 + 8 * fq;
        f32x4 sv[2][2];
#pragma unroll
        for (int bj = 0; bj < 2; ++bj)
#pragma unroll
            for (int n = 0; n < 2; ++n) sv[bj][n] = *(const f32x4*)(sw + col0 + bj * HALF + 4 * n);
        float rsv[2][4];
#pragma unroll
        for (int ai = 0; ai < 2; ++ai)
#pragma unroll
            for (int m = 0; m < 4; ++m) { const int r = row0 + ai * HALF + m * 16; rsv[ai][m] = __builtin_amdgcn_rsqf(ss[r] * (1.0f / 4096.0f) + 1e-6f) * sx[r]; }
#pragma unroll
        for (int ai = 0; ai < 2; ++ai)
#pragma unroll
            for (int m = 0; m < 4; ++m) { const int r = row0 + ai * HALF + m * 16; const float rs = rsv[ai][m]; bf16_t* rowp = O + (size_t)r * ldc + col0;
#pragma unroll
                for (int bj = 0; bj < 2; ++bj) { f32x4 v0 = __builtin_convertvector(acc[ai][bj][m][0], f32x4) * rs * sv[bj][0], v1 = __builtin_convertvector(acc[ai][bj][m][1], f32x4) * rs * sv[bj][1];
#pragma unroll
                    for (int j = 0; j < 4; ++j) { const float a = v0[j] > 0.f ? v0[j] : 0.f, b = v1[j] > 0.f ? v1[j] : 0.f; v0[j] = a * a; v1[j] = b * b; }
                    *(u32x4*)(rowp + bj * HALF) = pack8(v0, v1); } }
    }
};
struct EpiLora {
    static constexpr bool PERM = true, AFTER_DRAIN = false;
    bf16_t* EAG; const float* w0; const float* a0; size_t third_stride;
    __device__ __forceinline__ void operator()(AccRef acc, const Unit& u, int wr, int wc, int fr, int fq) const {
        const int row0 = u.pm * BM + wr * 64 + fr, third = u.pn >> 3, colt = (u.pn & 7) * 256;
        bf16_t* base = EAG + (size_t)third * third_stride;
        const int col0 = colt + wc * 32 + 8 * fq;
        const float* bvec = third == 0 ? w0 : a0;
        f32x4 bv[2][2];
#pragma unroll
        for (int bj = 0; bj < 2; ++bj)
#pragma unroll
            for (int n = 0; n < 2; ++n) bv[bj][n] = third < 2 ? *(const f32x4*)(bvec + col0 + bj * HALF + 4 * n) : (f32x4){0.f, 0.f, 0.f, 0.f};
        const float mul = third == 0 ? 0.6065306597126334f : 1.0f;
#pragma unroll
        for (int ai = 0; ai < 2; ++ai)
#pragma unroll
            for (int m = 0; m < 4; ++m) { const int r = row0 + ai * HALF + m * 16; bf16_t* rowp = base + (size_t)r * 2048 + col0;
#pragma unroll
                for (int bj = 0; bj < 2; ++bj) { f32x4 v0 = acc[ai][bj][m][0] + bv[bj][0], v1 = acc[ai][bj][m][1] + bv[bj][1];
                    if (third < 2) { v0 = sig4(v0) * mul; v1 = sig4(v1) * mul; }
                    *(u32x4*)(rowp + bj * HALF) = pack8(v0, v1); } }
    }
};
template <int MODE> struct EpiB {
    static constexpr bool PERM = true, AFTER_DRAIN = false;
    bf16_t* O; int ldc; const float* rstd; const bf16_t* GT; const bf16_t* AD; unsigned* RM;
    struct RowIn { u32x4 g[2], a[2]; };
    __device__ __forceinline__ void load_row(RowIn& R, int r, int col0) const {
#pragma unroll
        for (int bj = 0; bj < 2; ++bj) {
            if (MODE == 2) R.g[bj] = *(const u32x4*)(GT + (size_t)r * 8192 + col0 + bj * HALF);
            if (MODE == 3) { R.g[bj] = *(const u32x4*)(GT + (size_t)r * 8192 + 4096 + col0 + bj * HALF); R.a[bj] = *(const u32x4*)(AD + (size_t)r * 4096 + col0 + bj * HALF); } }
    }
    __device__ __forceinline__ void operator()(AccRef acc, const Unit& u, int wr, int wc, int fr, int fq) const {
        const int row0 = u.pm * BM + wr * 64 + fr, col0 = u.pn * BM + wc * 32 + 8 * fq;
        RowIn cur, nxt;
        if (MODE >= 2) load_row(cur, row0, col0);
#pragma unroll
        for (int s = 0; s < 8; ++s) { const int ai = s >> 2, m = s & 3; const int r = row0 + ai * HALF + m * 16; bf16_t* rowp = O + (size_t)r * ldc + col0;
                if (MODE >= 2 && s + 1 < 8) load_row(nxt, row0 + ((s + 1) >> 2) * HALF + ((s + 1) & 3) * 16, col0);
                float rs = 1.f; if (MODE == 1) rs = __builtin_amdgcn_rsqf(rstd[r] * (1.0f / 4096.0f) + 1e-6f);
                float mx = 0.f;
#pragma unroll
                for (int bj = 0; bj < 2; ++bj) { f32x4 v0 = acc[ai][bj][m][0], v1 = acc[ai][bj][m][1];
                    if (MODE == 1) { v0 = v0 * rs; v1 = v1 * rs;
#pragma unroll
                        for (int j = 0; j < 4; ++j) { const float a = v0[j] > 0.f ? v0[j] : 0.f, b = v1[j] > 0.f ? v1[j] : 0.f; v0[j] = a * a; v1[j] = b * b; } }
                    if (MODE == 2) { f32x4 g0, g1; unpack8(cur.g[bj], g0, g1); v0 = v0 * g0; v1 = v1 * g1; }
                    if (MODE == 3) { f32x4 g0, g1, a0, a1; unpack8(cur.g[bj], g0, g1); unpack8(cur.a[bj], a0, a1);
                        v0 = a0 + v0 * g0; v1 = a1 + v1 * g1;
#pragma unroll
                        for (int j = 0; j < 4; ++j) mx = fmaxf(mx, fmaxf(fabsf(v0[j]), fabsf(v1[j]))); }
                    *(u32x4*)(rowp + bj * HALF) = pack8(v0, v1); }
                if (MODE == 3) { mx = fmaxf(mx, __shfl_xor(mx, 16)); mx = fmaxf(mx, __shfl_xor(mx, 32)); if (fq == 0) atomicMax(RM + r, __builtin_bit_cast(unsigned, mx)); }
                if (MODE >= 2) cur = nxt; }
    }
};
template <int MODE, bool I8 = false> struct EpiF {
    static constexpr bool PERM = false, AFTER_DRAIN = false;
    const float* res; float* out; const float* rstd; const bf16_t* PP; bf16_t* XB; float* SS; unsigned* RM;
    const float* sxr; const float* swc;
    struct RowIn { f32x4 b[2][2]; u32x2 pw[2][2]; };
    __device__ __forceinline__ void load_row(RowIn& R, size_t off) const {
#pragma unroll
        for (int bj = 0; bj < 2; ++bj)
#pragma unroll
            for (int n = 0; n < 2; ++n) { const size_t o = off + bj * HALF + n * 16; R.b[bj][n] = *(const f32x4*)(res + o); if (MODE == 1) R.pw[bj][n] = *(const u32x2*)(PP + o); }
    }
    __device__ __forceinline__ void operator()(const typename AccT<I8>::type (&acc)[2][2][4][2], const Unit& u, int wr, int wc, int fr, int fq) const {
        const int row0 = u.pm * BM + wr * 64 + fr, col0 = u.pn * BM + wc * 32 + 4 * fq;
        f32x4 sv[2][2];
        if (I8) {
#pragma unroll
            for (int bj = 0; bj < 2; ++bj)
#pragma unroll
                for (int n = 0; n < 2; ++n) sv[bj][n] = *(const f32x4*)(swc + col0 + bj * HALF + n * 16);
        }
        float rsv[8];
#pragma unroll
        for (int s = 0; s < 8; ++s) { const int r = row0 + (s >> 2) * HALF + (s & 3) * 16; float rs = 1.f; if (MODE == 1) rs = __builtin_amdgcn_rsqf(rstd[r] * (1.0f / 4096.0f) + 1e-6f); if (I8) rs *= sxr[r]; rsv[s] = rs; }
        RowIn cur, nxt;
        load_row(cur, (size_t)row0 * 4096 + col0);
#pragma unroll
        for (int s = 0; s < 8; ++s) { const int ai = s >> 2, m = s & 3; const int r = row0 + ai * HALF + m * 16; const size_t off = (size_t)r * 4096 + col0;
                if (s + 1 < 8) load_row(nxt, (size_t)(row0 + ((s + 1) >> 2) * HALF + ((s + 1) & 3) * 16) * 4096 + col0);
                const float rs = rsv[s];
                float ss = 0.f, mx = 0.f;
#pragma unroll
                for (int bj = 0; bj < 2; ++bj)
#pragma unroll
                    for (int n = 0; n < 2; ++n) { const size_t o = off + bj * HALF + n * 16; const f32x4 b = cur.b[bj][n]; f32x4 v;
                        if constexpr (I8) v = __builtin_convertvector(acc[ai][bj][m][n], f32x4) * rs * sv[bj][n]; else v = acc[ai][bj][m][n];
                        if (MODE == 1) { const u32x2 pw = cur.pw[bj][n]; const f32x4 pp = (f32x4){bf_lo(pw.x), bf_hi(pw.x), bf_lo(pw.y), bf_hi(pw.y)}; v = sig4(I8 ? v : v * rs) * pp; }
                        const f32x4 x = b + v; *(f32x4*)(out + o) = x;
                        if (MODE == 0 && XB) { u32x2 w; w.x = cvt_pk_bf16(x[0], x[1]); w.y = cvt_pk_bf16(x[2], x[3]); *(u32x2*)(XB + o) = w; ss += (x[0] * x[0] + x[1] * x[1]) + (x[2] * x[2] + x[3] * x[3]);
                            if (RM) mx = fmaxf(fmaxf(mx, fmaxf(fabsf(x[0]), fabsf(x[1]))), fmaxf(fabsf(x[2]), fabsf(x[3]))); } }
                if (MODE == 0 && XB) { ss += __shfl_xor(ss, 16); ss += __shfl_xor(ss, 32); if (fq == 0) unsafeAtomicAdd(SS + r, ss);
                    if (RM) { mx = fmaxf(mx, __shfl_xor(mx, 16)); mx = fmaxf(mx, __shfl_xor(mx, 32)); if (fq == 0) atomicMax(RM + r, __builtin_bit_cast(unsigned, mx)); } }
                cur = nxt; }
    }
};
}
constexpr int NWAVES = 8;
constexpr int SEQ = 4096, M = 16384, D = 4096;
constexpr int NQKV = 4608, NZP = 6656, NGT = 8192, NINP = 19456, NIN = 19392, NINA = 11264;
constexpr int RWW = 2048, DFF = 16384, PLE = 256, AOW = 512, LORAK = 512, LORAN = 6144;
#ifndef MK_ONE_LAUNCH
#define MK_ONE_LAUNCH 1
#endif
constexpr int NPH = 15;
enum { P_PRO = 0, G_WIN, T_ATTN, G_LORA, T_SCAN, T_CARRY, T_FIX, G_ATTUP, G_RWUP, G_OUT, T_N2, G_MLPIN, G_MLPOUT, G_PP, G_PLE };

constexpr size_t MiB = 1u << 20;
constexpr size_t WS_CTL = 0, CTL_ZERO_BYTES = 1 * MiB;
constexpr size_t WS_WIN = 2 * MiB;
constexpr size_t WS_WMLPIN = 2 * MiB;
constexpr size_t WS_WATT = 154 * MiB;
constexpr size_t WS_WLORA = 158 * MiB;
constexpr size_t WS_WRW = 164 * MiB;
constexpr size_t WS_WOUT = 180 * MiB;
constexpr size_t WS_XB = 212 * MiB;
constexpr size_t WS_QKV = 340 * MiB;
constexpr size_t WS_AD = 340 * MiB;
constexpr size_t WS_Z = 484 * MiB;
constexpr size_t WS_MERGED = 484 * MiB;
constexpr size_t WS_GT = 692 * MiB;
constexpr size_t WS_ATT = 948 * MiB;
constexpr size_t WS_RW = 964 * MiB;
constexpr size_t WS_EAG = 1028 * MiB;
constexpr size_t WS_ALORA = 1220 * MiB;
constexpr size_t WS_RSTD = 1236 * MiB;
constexpr size_t WS_PB = 1237 * MiB;
constexpr size_t WS_HID = 340 * MiB;
constexpr size_t WS_WMLPOUT = 852 * MiB;
constexpr size_t WS_WPLEG = 980 * MiB;
constexpr size_t WS_WPLEP = 1012 * MiB;
constexpr size_t WS_PP = 1014 * MiB;
constexpr size_t WS_YLOC = 212 * MiB;
constexpr size_t WS_GBUF = 340 * MiB;
constexpr size_t WS_LST = 130 * MiB;
constexpr size_t WS_TST = 1220 * MiB;
constexpr size_t WS_RKB = 146 * MiB;
constexpr size_t WS_OG = 964 * MiB;
constexpr size_t WS_LSE = 1012 * MiB;
constexpr size_t WS_WIN8 = 2 * MiB;
constexpr size_t WS_WZT = 78 * MiB;
constexpr size_t WS_X8 = 1028 * MiB;
constexpr size_t WS_SX = 1236 * MiB + 256 * 1024, WS_SW = 1236 * MiB + 384 * 1024;
constexpr size_t WS_W8M = 2 * MiB;
constexpr size_t WS_X8B = 130 * MiB;
constexpr size_t WS_SWM = 1236 * MiB + 512 * 1024, WS_SX2 = 1236 * MiB + 576 * 1024;
constexpr size_t WS_W8O = 180 * MiB;
constexpr size_t WS_W8P = 980 * MiB;
constexpr size_t WS_X8C = 340 * MiB;
constexpr size_t WS_X8D = 130 * MiB;
constexpr size_t WS_SWO = 1236 * MiB + 640 * 1024, WS_SWP = 1236 * MiB + 656 * 1024, WS_SX3 = 1236 * MiB + 704 * 1024, WS_SX4 = 1236 * MiB + 768 * 1024;
constexpr size_t WS_END = 1245 * MiB;
constexpr int CW_BAR = 4096;
constexpr size_t CTL_CMAX = 512 * 1024;
constexpr size_t CTL_RMAX2 = 704 * 1024;
constexpr size_t CTL_RMAX3 = 768 * 1024, CTL_RMAX4 = 832 * 1024;
constexpr size_t CTL_CMAXO = 896 * 1024, CTL_CMAXP = 912 * 1024;
constexpr size_t CTL_QCNT = 944 * 1024;
constexpr size_t CTL_SS2 = 256 * 1024, CTL_SS3 = 384 * 1024;

constexpr int RING_OFF = 0, RING_BYTES = 131072;
constexpr int LDSCTL_OFF = 163328, MISC_OFF = LDSCTL_OFF + 320;
constexpr int LDS_BYTES = 163840;

#define GAS __attribute__((address_space(1)))
#define LAS __attribute__((address_space(3)))
typedef unsigned short bf16;
typedef unsigned v4u __attribute__((ext_vector_type(4)));
typedef unsigned v2u __attribute__((ext_vector_type(2)));
typedef unsigned u32x4_t __attribute__((ext_vector_type(4)));
typedef float f32x4 __attribute__((ext_vector_type(4)));
typedef GAS unsigned gu32;
#define RLX_AGENT __ATOMIC_RELAXED, __HIP_MEMORY_SCOPE_AGENT
#define LDS_WAIT() asm volatile("s_waitcnt lgkmcnt(0)" ::: "memory")
__device__ __forceinline__ unsigned pk2(float lo, float hi) { return pg8::cvt_pk_bf16_n(lo, hi); }
__device__ __forceinline__ unsigned f2bf(float f) { return pg8::cvt_pk_bf16_n(f, 0.f) & 0xffffu; }
__device__ __forceinline__ float blo(unsigned w) { return __builtin_bit_cast(float, w << 16); }
__device__ __forceinline__ float bhi(unsigned w) { return __builtin_bit_cast(float, w & 0xffff0000u); }
__device__ __forceinline__ float bf1(bf16 h) { return __builtin_bit_cast(float, (unsigned)h << 16); }

template <int CTRL> __device__ __forceinline__ float dppf(float v) { return __builtin_bit_cast(float, __builtin_amdgcn_update_dpp(0, __builtin_bit_cast(int, v), CTRL, 0xf, 0xf, true)); }
__device__ __forceinline__ float red8(float v) { v += dppf<0xB1>(v); v += dppf<0x4E>(v); v += dppf<0x141>(v); return v; }
__device__ __forceinline__ float wave_sum_dpp(float v) {
    v += dppf<0xB1>(v); v += dppf<0x4E>(v); v += dppf<0x141>(v); v += dppf<0x140>(v);
    v += __builtin_bit_cast(float, __builtin_amdgcn_update_dpp(0, __builtin_bit_cast(int, v), 0x142, 0xa, 0xf, false));
    v += __builtin_bit_cast(float, __builtin_amdgcn_update_dpp(0, __builtin_bit_cast(int, v), 0x143, 0xc, 0xf, false));
    return __builtin_bit_cast(float, __builtin_amdgcn_readlane(__builtin_bit_cast(int, v), 63));
}

#define WG_BAR_LDS() do { asm volatile("s_waitcnt lgkmcnt(0)" ::: "memory"); __builtin_amdgcn_s_barrier(); asm volatile("" ::: "memory"); } while (0)
#define XB_TMO      128
#define XB_XCNT(j)  (256  + 64 * (j))
#define XB_XSUB(j)  (1280 + 64 * (j))
#define XB_XGEN(j)  (2304 + 64 * (j))
#define XB_TOP      3328
#define XB_TOPGEN   3392
#define XCD_BAR_WORDS 3456
#define XB_SPIN_CAP (1u << 18)

__device__ __forceinline__ unsigned xb_ld(unsigned* p)              { return __hip_atomic_load(p, __ATOMIC_RELAXED, __HIP_MEMORY_SCOPE_AGENT); }
__device__ __forceinline__ unsigned xb_add(unsigned* p, unsigned v) { return __hip_atomic_fetch_add(p, v, __ATOMIC_RELAXED, __HIP_MEMORY_SCOPE_AGENT); }
__device__ __forceinline__ unsigned xb_xcc_id() { return (unsigned)__builtin_amdgcn_s_getreg((3 << 11) | 20) & 0xFu; }
#define XB_SPIN(cond, bar) do { unsigned _sp = 0; while (cond) { __builtin_amdgcn_s_sleep(1); \
    if ((++_sp & 255u) == 0u) { if (xb_ld(&(bar)[XB_TMO])) break; if (_sp > XB_SPIN_CAP) { atomicAdd(&(bar)[XB_TMO], 1u); break; } } } } while (0)

struct XcdBarrier {
    unsigned* bar; unsigned x;
    volatile LAS unsigned* st;
};

__device__ __forceinline__ XcdBarrier xcd_barrier_post(unsigned* bar, volatile LAS unsigned* st) {
    XcdBarrier b; b.bar = bar; b.x = xb_xcc_id(); b.st = st;
    if (threadIdx.x == 0) (void)xb_add(&bar[XB_XCNT(b.x)], 1u);
    return b;
}
__device__ __forceinline__ void xcd_barrier_complete(unsigned* bar, unsigned x, unsigned& nloc, unsigned& nx) {
    const unsigned G = gridDim.x * gridDim.y * gridDim.z;
    unsigned sum, cnt, mine, sp = 0u;
    for (;;) {
        sum = 0u; cnt = 0u; mine = 0u;
#pragma unroll
        for (unsigned j = 0; j < 16; ++j) { const unsigned c = xb_ld(&bar[XB_XCNT(j)]); sum += c; cnt += (c > 0u) ? 1u : 0u; mine = (j == x) ? c : mine; }
        if (sum == G) break;
        __builtin_amdgcn_s_sleep(1);
        if ((++sp & 255u) == 0u) { if (xb_ld(&bar[XB_TMO])) break; if (sp > XB_SPIN_CAP) { atomicAdd(&bar[XB_TMO], 1u); break; } }
    }
    nloc = mine > 0u ? mine : 1u; nx = cnt > 0u ? cnt : 1u;
}

__device__ __forceinline__ void xcd_barrier(const XcdBarrier& b) {
    asm volatile("s_waitcnt vmcnt(0)" ::: "memory");
    __syncthreads();
    if (threadIdx.x == 0) {
        unsigned* bar = b.bar;
        __builtin_amdgcn_s_waitcnt(0);
        unsigned nloc = b.st[0], nx = b.st[1];
        if (nloc == 0u) { xcd_barrier_complete(bar, b.x, nloc, nx); b.st[0] = nloc; b.st[1] = nx; }
        const unsigned old = xb_add(&bar[XB_XSUB(b.x)], 1u);
        const unsigned gen = old / nloc;
        if (old + 1u == (gen + 1u) * nloc) {
            __builtin_amdgcn_fence(__ATOMIC_RELEASE, "agent");
            asm volatile("s_waitcnt vmcnt(0)" ::: "memory");
            const unsigned og = xb_add(&bar[XB_TOP], 1u);
            const unsigned tg = og / nx;
            if (og + 1u == (tg + 1u) * nx) xb_add(&bar[XB_TOPGEN], 1u);
            else XB_SPIN(xb_ld(&bar[XB_TOPGEN]) == tg, bar);
            __builtin_amdgcn_fence(__ATOMIC_ACQUIRE, "agent");
            xb_add(&bar[XB_XGEN(b.x)], 1u);
            asm volatile("s_waitcnt vmcnt(0)" ::: "memory");
        } else {
            XB_SPIN(xb_ld(&bar[XB_XGEN(b.x)]) == gen, bar);
            __builtin_amdgcn_fence(__ATOMIC_ACQUIRE, "agent");
            asm volatile("s_waitcnt vmcnt(0)" ::: "memory");
        }
    }
    __syncthreads();
}
struct Frame {
    LAS unsigned char* lds;
    volatile LAS unsigned* MISC;
    gu32* ctl;
    int tid, lane, wave;
    int vcu, G;
    const float* in[27];
    float* out;
    unsigned char* ws;
};
__device__ __forceinline__ float wave_sum(float v) {
#pragma unroll
    for (int o = 1; o < 64; o <<= 1) v += __shfl_xor(v, o);
    return v;
}
struct TrTile { f32x4 v[16]; };
__device__ __forceinline__ void tr_load(TrTile& T, const float* W, int N, int nb0, int nblk, int item, int lane) {
    const int kb = item / nblk, nb = nb0 + item % nblk, k0 = 64 * kb, n0 = 64 * nb, lr = lane >> 4, lc = lane & 15;
#pragma unroll
    for (int i = 0; i < 16; ++i) T.v[i] = __builtin_nontemporal_load((const f32x4*)(W + (size_t)(k0 + 4 * i + lr) * N + n0 + 4 * lc));
}
__device__ __forceinline__ void tr_store(const TrTile& T, int K, int nb0, int nblk, bf16* WT, const float* gk, int pad_from, int pad, LAS float* scr, int item, int lane) {
    const int kb = item / nblk, nb = nb0 + item % nblk, k0 = 64 * kb, n0 = 64 * nb, lr = lane >> 4, lc = lane & 15;
#pragma unroll
    for (int i = 0; i < 16; ++i) { const float g = gk ? gk[k0 + 4 * i + lr] : 1.0f; LAS float* s = scr + (4 * i + lr) * 65 + 4 * lc; s[0] = T.v[i].x * g; s[1] = T.v[i].y * g; s[2] = T.v[i].z * g; s[3] = T.v[i].w * g; }
    LDS_WAIT(); asm volatile("" ::: "memory");
    const int c = lane & 7, roff = n0 >= pad_from ? pad : 0;
#pragma unroll
    for (int j = 0; j < 8; ++j) { const int n = (lane >> 3) + 8 * j; const LAS float* s = scr + (8 * c) * 65 + n;
        v4u o; o.x = pk2(s[0 * 65], s[1 * 65]); o.y = pk2(s[2 * 65], s[3 * 65]); o.z = pk2(s[4 * 65], s[5 * 65]); o.w = pk2(s[6 * 65], s[7 * 65]);
        *(v4u*)(WT + (size_t)(roff + n0 + n) * K + k0 + 8 * c) = o; }
    LDS_WAIT(); asm volatile("" ::: "memory");
}
__device__ __forceinline__ void transpose_item_lowreg(const float* W, int K, int N, bf16* WT, const float* gk, LAS float* scr, int item, int lane) {
    const int nblk = N / 64, kb = item / nblk, nb = item % nblk, k0 = 64 * kb, n0 = 64 * nb, lr = lane >> 4, lc = lane & 15;
#pragma unroll 1
    for (int ig = 0; ig < 4; ++ig) { f32x4 v[4];
#pragma unroll
        for (int i = 0; i < 4; ++i) v[i] = *(const f32x4*)(W + (size_t)(k0 + 16 * ig + 4 * i + lr) * N + n0 + 4 * lc);
#pragma unroll
        for (int i = 0; i < 4; ++i) { const float g = gk[k0 + 16 * ig + 4 * i + lr]; LAS float* s = scr + (16 * ig + 4 * i + lr) * 65 + 4 * lc; s[0] = v[i].x * g; s[1] = v[i].y * g; s[2] = v[i].z * g; s[3] = v[i].w * g; } }
    LDS_WAIT(); asm volatile("" ::: "memory");
    const int c = lane & 7;
#pragma unroll 1
    for (int j = 0; j < 8; ++j) { const int n = (lane >> 3) + 8 * j; const LAS float* s = scr + (8 * c) * 65 + n;
        v4u o; o.x = pk2(s[0 * 65], s[1 * 65]); o.y = pk2(s[2 * 65], s[3 * 65]); o.z = pk2(s[4 * 65], s[5 * 65]); o.w = pk2(s[6 * 65], s[7 * 65]);
        *(v4u*)(WT + (size_t)(n0 + n) * K + k0 + 8 * c) = o; }
    LDS_WAIT(); asm volatile("" ::: "memory");
}
__device__ __forceinline__ void transpose_matrix(Frame& F, const float* W, int K, int N, bf16* WT, const float* gk, int pad_from, int pad, int nb0 = 0, int nblk = -1, int rank = -1, int nrank = 0) {
    if (nblk < 0) nblk = N / 64;
    if (rank < 0) { rank = F.vcu; nrank = F.G; }
    LAS float* scr = (LAS float*)(F.lds + RING_OFF + F.wave * 16640);
    const int gw = rank * NWAVES + F.wave, NGW = nrank * NWAVES, nitems = (K / 64) * nblk;
    TrTile A, B; int it = gw;
    if (it < nitems) tr_load(A, W, N, nb0, nblk, it, F.lane);
    while (it < nitems) {
        const int itb = it + NGW;
        if (itb < nitems) tr_load(B, W, N, nb0, nblk, itb, F.lane);
        tr_store(A, K, nb0, nblk, WT, gk, pad_from, pad, scr, it, F.lane);
        if (itb >= nitems) break;
        it = itb + NGW;
        if (it < nitems) tr_load(A, W, N, nb0, nblk, it, F.lane);
        tr_store(B, K, nb0, nblk, WT, gk, pad_from, pad, scr, itb, F.lane);
    }
}
__device__ __forceinline__ void colmax_sweep(Frame& F, const float* W, int K, int N, const float* gk, unsigned* cmax, int skip_from, int skip_cnt, int pad_from, int rank, int nrank) {
    const int lane = F.lane, lr = lane >> 4, lc = lane & 15, wave = F.wave, nblk = N / 64, nbe = nblk - skip_cnt; LAS float* red = (LAS float*)(F.lds + RING_OFF);
    for (int it = rank; it < nbe * 4; it += nrank) { const int eb = it % nbe, kq = it / nbe, nbr = eb < skip_from ? eb : eb + skip_cnt;
        f32x4 m = (f32x4){0.f, 0.f, 0.f, 0.f};
#pragma unroll
        for (int h = 0; h < 2; ++h) { const int kb = kq * 16 + wave * 2 + h; TrTile T; tr_load(T, W, N, 0, nblk, kb * nblk + nbr, lane); const int k0 = 64 * kb;
#pragma unroll
            for (int i = 0; i < 16; ++i) { const float g = gk ? gk[k0 + 4 * i + lr] : 1.0f; m.x = fmaxf(m.x, fabsf(T.v[i].x * g)); m.y = fmaxf(m.y, fabsf(T.v[i].y * g)); m.z = fmaxf(m.z, fabsf(T.v[i].z * g)); m.w = fmaxf(m.w, fabsf(T.v[i].w * g)); } }
#pragma unroll
        for (int e = 0; e < 4; ++e) { float v = m[e]; v = fmaxf(v, __shfl_xor(v, 16)); v = fmaxf(v, __shfl_xor(v, 32)); m[e] = v; }
        __syncthreads();
        if (lr == 0) *(LAS f32x4*)(red + wave * 64 + 4 * lc) = m;
        __syncthreads();
        if (wave == 0) { float v = red[lane];
#pragma unroll
            for (int w = 1; w < NWAVES; ++w) v = fmaxf(v, red[w * 64 + lane]);
            const int n = nbr * 64 + lane;
            atomicMax(cmax + n + (n >= pad_from ? 64 : 0), __builtin_bit_cast(unsigned, v)); }
    }
}
__device__ __forceinline__ unsigned q8(float x) { return (unsigned)(int)__builtin_rintf(x) & 0xffu; }
struct TrTileQ { f32x4 v[16]; };
__device__ __forceinline__ void trq_load(TrTileQ& T, const float* W, int N, int col0, int nblk32, int item, int lane) {
    const int kb = item / nblk32, nbr = item % nblk32, k0 = 128 * kb, n0 = col0 + 32 * nbr;
#pragma unroll
    for (int i = 0; i < 16; ++i) T.v[i] = __builtin_nontemporal_load((const f32x4*)(W + (size_t)(k0 + 8 * i + (lane >> 3)) * N + n0 + 4 * (lane & 7)));
}
__device__ __forceinline__ void trq_store(const TrTileQ& T, int K, int nblk32, signed char* W8, const float* gk, const unsigned* cmax, float* sw, LAS float* scr, int item, int lane) {
    const int kb = item / nblk32, nbr = item % nblk32, k0 = 128 * kb, n0 = 32 * nbr;
#pragma unroll
    for (int i = 0; i < 16; ++i) { const int row = 8 * i + (lane >> 3); const float g = gk[k0 + row]; LAS float* s = scr + row * 33 + 4 * (lane & 7); s[0] = T.v[i].x * g; s[1] = T.v[i].y * g; s[2] = T.v[i].z * g; s[3] = T.v[i].w * g; }
    LDS_WAIT(); asm volatile("" ::: "memory");
    const int c = lane & 7;
#pragma unroll
    for (int j = 0; j < 4; ++j) { const int n = (lane >> 3) + 8 * j; const LAS float* s = scr + (16 * c) * 33 + n;
        const float cm = __builtin_bit_cast(float, cmax[n0 + n]), inv = cm > 0.f ? 127.0f / cm : 0.f;
        v4u o;
        o.x = q8(s[0 * 33] * inv) | (q8(s[1 * 33] * inv) << 8) | (q8(s[2 * 33] * inv) << 16) | (q8(s[3 * 33] * inv) << 24);
        o.y = q8(s[4 * 33] * inv) | (q8(s[5 * 33] * inv) << 8) | (q8(s[6 * 33] * inv) << 16) | (q8(s[7 * 33] * inv) << 24);
        o.z = q8(s[8 * 33] * inv) | (q8(s[9 * 33] * inv) << 8) | (q8(s[10 * 33] * inv) << 16) | (q8(s[11 * 33] * inv) << 24);
        o.w = q8(s[12 * 33] * inv) | (q8(s[13 * 33] * inv) << 8) | (q8(s[14 * 33] * inv) << 16) | (q8(s[15 * 33] * inv) << 24);
        *(v4u*)(W8 + (size_t)(n0 + n) * K + k0 + 16 * c) = o;
        if (kb == 0 && c == 0) sw[n0 + n] = cm * (1.0f / 127.0f); }
    LDS_WAIT(); asm volatile("" ::: "memory");
}
__device__ __forceinline__ void quantize_matrix(Frame& F, const float* W, int K, int N, signed char* W8, const float* gk, const unsigned* cmax, float* sw, int skip_from, int skip_cnt, int pad_from) {
    const int gw = F.vcu * NWAVES + F.wave, NGW = F.G * NWAVES, nbe = N / 64 - skip_cnt, nitems = (K / 128) * nbe, lane = F.lane;
    for (int it = gw; it < nitems; it += NGW) {
        const int kb = it / nbe, eb = it % nbe, nbr = eb < skip_from ? eb : eb + skip_cnt, k0 = 128 * kb, n = 64 * nbr + lane, dr = n + (n >= pad_from ? 64 : 0);
        const float cm = __builtin_bit_cast(float, cmax[dr]), inv = cm > 0.f ? 127.0f / cm : 0.f;
        const float* src = W + (size_t)k0 * N + n;
#pragma unroll 2
        for (int c = 0; c < 8; ++c) { unsigned o[4];
#pragma unroll
            for (int wq = 0; wq < 4; ++wq) { unsigned a = 0;
#pragma unroll
                for (int bq = 0; bq < 4; ++bq) { const int k = 16 * c + 4 * wq + bq; a |= q8(src[(size_t)k * N] * (gk ? gk[k0 + k] : 1.0f) * inv) << (8 * bq); }
                o[wq] = a; }
            *(v4u*)(W8 + (size_t)dr * K + k0 + 16 * c) = (v4u){o[0], o[1], o[2], o[3]}; }
        if (kb == 0) sw[dr] = cm * (1.0f / 127.0f);
    }
}
__device__ __forceinline__ void quantize_blocks_wg(Frame& F, const float* W, int N, const float* gk, signed char* W8, float* sw, int nblocks, int skip_from, int skip_cnt, int pad_from, int rank, int nrank) {
    constexpr int K = 4096;
    const int lane = F.lane, wave = F.wave, lr8 = lane >> 3, lc8 = lane & 7;
    LAS float* scr = (LAS float*)(F.lds + RING_OFF + wave * 16896); LAS float* red = (LAS float*)(F.lds + RING_OFF + 8 * 16896); LAS float* cmv = red + 8 * 32;
    for (int eb = rank; eb < nblocks; eb += nrank) { const int nb = eb < skip_from ? eb : eb + skip_cnt, dsh = (nb * 64 >= pad_from) ? 64 : 0;
#pragma unroll 1
        for (int h = 0; h < 2; ++h) {
            const int n0 = nb * 64 + 32 * h;
            f32x4 m = (f32x4){0.f, 0.f, 0.f, 0.f};
            for (int i = 0; i < 4; i += 2) { TrTileQ A, B; const int ka = 128 * (wave + 8 * i), kb = ka + 1024;
#pragma unroll
                for (int j = 0; j < 16; ++j) A.v[j] = *(const f32x4*)(W + (size_t)(ka + 8 * j + lr8) * N + n0 + 4 * lc8);
#pragma unroll
                for (int j = 0; j < 16; ++j) B.v[j] = *(const f32x4*)(W + (size_t)(kb + 8 * j + lr8) * N + n0 + 4 * lc8);
#pragma unroll
                for (int j = 0; j < 16; ++j) { const float g = gk ? gk[ka + 8 * j + lr8] : 1.0f; m.x = fmaxf(m.x, fabsf(A.v[j].x * g)); m.y = fmaxf(m.y, fabsf(A.v[j].y * g)); m.z = fmaxf(m.z, fabsf(A.v[j].z * g)); m.w = fmaxf(m.w, fabsf(A.v[j].w * g)); }
#pragma unroll
                for (int j = 0; j < 16; ++j) { const float g = gk ? gk[kb + 8 * j + lr8] : 1.0f; m.x = fmaxf(m.x, fabsf(B.v[j].x * g)); m.y = fmaxf(m.y, fabsf(B.v[j].y * g)); m.z = fmaxf(m.z, fabsf(B.v[j].z * g)); m.w = fmaxf(m.w, fabsf(B.v[j].w * g)); } }
#pragma unroll
            for (int e = 0; e < 4; ++e) { float v = m[e]; v = fmaxf(v, __shfl_xor(v, 8)); v = fmaxf(v, __shfl_xor(v, 16)); v = fmaxf(v, __shfl_xor(v, 32)); m[e] = v; }
            __syncthreads();
            if (lr8 == 0) *(LAS f32x4*)(red + wave * 32 + 4 * lc8) = m;
            __syncthreads();
            if (wave == 0 && lane < 32) { float v = red[lane];
#pragma unroll
                for (int w = 1; w < NWAVES; ++w) v = fmaxf(v, red[w * 32 + lane]);
                cmv[lane] = v; sw[n0 + lane + dsh] = v * (1.0f / 127.0f); }
            __syncthreads();
            TrTileQ T;
#pragma unroll
            for (int j = 0; j < 16; ++j) T.v[j] = *(const f32x4*)(W + (size_t)(128 * wave + 8 * j + lr8) * N + n0 + 4 * lc8);
            for (int i = 0; i < 4; ++i) { const int k0 = 128 * (wave + 8 * i);
#pragma unroll
                for (int j = 0; j < 16; ++j) { const int row = 8 * j + lr8; const float g = gk ? gk[k0 + row] : 1.0f; LAS float* s = scr + row * 33 + 4 * lc8; s[0] = T.v[j].x * g; s[1] = T.v[j].y * g; s[2] = T.v[j].z * g; s[3] = T.v[j].w * g; }
                if (i + 1 < 4) {
#pragma unroll
                    for (int j = 0; j < 16; ++j) T.v[j] = *(const f32x4*)(W + (size_t)(k0 + 1024 + 8 * j + lr8) * N + n0 + 4 * lc8); }
                LDS_WAIT(); asm volatile("" ::: "memory");
                const int c = lc8;
#pragma unroll
                for (int j = 0; j < 4; ++j) { const int n = lr8 + 8 * j; const LAS float* s = scr + (16 * c) * 33 + n;
                    const float cm = cmv[n], inv = cm > 0.f ? 127.0f / cm : 0.f;
                    v4u o;
                    o.x = q8(s[0 * 33] * inv) | (q8(s[1 * 33] * inv) << 8) | (q8(s[2 * 33] * inv) << 16) | (q8(s[3 * 33] * inv) << 24);
                    o.y = q8(s[4 * 33] * inv) | (q8(s[5 * 33] * inv) << 8) | (q8(s[6 * 33] * inv) << 16) | (q8(s[7 * 33] * inv) << 24);
                    o.z = q8(s[8 * 33] * inv) | (q8(s[9 * 33] * inv) << 8) | (q8(s[10 * 33] * inv) << 16) | (q8(s[11 * 33] * inv) << 24);
                    o.w = q8(s[12 * 33] * inv) | (q8(s[13 * 33] * inv) << 8) | (q8(s[14 * 33] * inv) << 16) | (q8(s[15 * 33] * inv) << 24);
                    *(v4u*)(W8 + (size_t)(n0 + n + dsh) * K + k0 + 16 * c) = o; }
                LDS_WAIT(); asm volatile("" ::: "memory"); }
            __syncthreads();
        }
    }
}
struct QTile { f32x4 v[16]; };
__device__ __forceinline__ void q16_load(QTile& T, const float* W, int N, int n0, int hb, int wave, int lane) {
    const unsigned off0 = ((unsigned)(hb * 2048 + wave * 16 + (lane >> 2)) * (unsigned)N + (unsigned)(n0 + 4 * (lane & 3))) * 4u, step = (unsigned)N * 512u;
#pragma unroll
    for (int i = 0; i < 16; ++i) T.v[i] = *(const f32x4*)((const char*)W + (off0 + (unsigned)i * step));
}
__device__ __forceinline__ void q16_image(const QTile& T, f32x4& m, const float* gk, LAS unsigned char* img, int hb, int wave, int lane) {
    const int r4 = lane >> 2, c4 = lane & 3;
#pragma unroll
    for (int i = 0; i < 16; ++i) { const int row = (hb * 16 + i) * 128 + wave * 16 + r4; const float g = gk ? gk[row] : 1.0f; const f32x4 x = T.v[i] * g;
        m.x = fmaxf(m.x, fabsf(x.x)); m.y = fmaxf(m.y, fabsf(x.y)); m.z = fmaxf(m.z, fabsf(x.z)); m.w = fmaxf(m.w, fabsf(x.w));
        v2u w; w.x = pk2(x.x, x.y); w.y = pk2(x.z, x.w); *(LAS v2u*)(img + row * 32 + (row >> 4) * 32 + c4 * 8) = w; }
}
__device__ __forceinline__ void quantize_cols16_wg(Frame& F, const float* W, int N, const float* gk, signed char* W8, float* sw, int nblocks, int skip_from, int skip_cnt, int pad_from, int rank, int nrank) {
    constexpr int K = 4096;
    const int lane = F.lane, wave = F.wave, r4 = lane >> 2, c4 = lane & 3;
    LAS unsigned char* img = F.lds + RING_OFF; LAS float* red = (LAS float*)(F.lds + RING_OFF + 139264); LAS float* cmv = red + 8 * 16;
    QTile A, B;
    for (int eb = rank; eb < nblocks; eb += nrank) {
        const int b16 = eb < skip_from ? eb : eb + skip_cnt, n0 = b16 * 16, dsh = (n0 >= pad_from) ? 64 : 0;
        f32x4 m = (f32x4){0.f, 0.f, 0.f, 0.f};
        q16_load(A, W, N, n0, 0, wave, lane);
        q16_load(B, W, N, n0, 1, wave, lane);
        q16_image(A, m, gk, img, 0, wave, lane);
        q16_image(B, m, gk, img, 1, wave, lane);
#pragma unroll
        for (int e = 0; e < 4; ++e) { float v = m[e]; v = fmaxf(v, __shfl_xor(v, 4)); v = fmaxf(v, __shfl_xor(v, 8)); v = fmaxf(v, __shfl_xor(v, 16)); v = fmaxf(v, __shfl_xor(v, 32)); m[e] = v; }
        if (r4 == 0) *(LAS f32x4*)(red + wave * 16 + 4 * c4) = m;
        WG_BAR_LDS();
        if (F.tid < 16) { float v = red[F.tid];
#pragma unroll
            for (int w = 1; w < NWAVES; ++w) v = fmaxf(v, red[w * 16 + F.tid]);
            cmv[F.tid] = v; sw[n0 + F.tid + dsh] = v * (1.0f / 127.0f); }
        WG_BAR_LDS();
        { const int n = lane & 15, kc = lane >> 4; const float cm = cmv[n], inv = cm > 0.f ? 127.0f / cm : 0.f;
#pragma unroll 2
            for (int it = 0; it < 8; ++it) { const int ch = (it * 8 + wave) * 4 + kc;
                const LAS bf16* s = (const LAS bf16*)(img + ch * 544) + n;
                unsigned o[4];
#pragma unroll
                for (int q = 0; q < 4; ++q) o[q] = q8(bf1(s[(4 * q) * 16]) * inv) | (q8(bf1(s[(4 * q + 1) * 16]) * inv) << 8) | (q8(bf1(s[(4 * q + 2) * 16]) * inv) << 16) | (q8(bf1(s[(4 * q + 3) * 16]) * inv) << 24);
                *(v4u*)(W8 + (size_t)(n0 + n + dsh) * K + ch * 16) = (v4u){o[0], o[1], o[2], o[3]}; } }
        WG_BAR_LDS();
    }
}
__device__ __forceinline__ void q32_pass2(LAS unsigned char* img, const LAS float* cmv, signed char* W8row0, int kbase, int wave, int lane) {
    const int n = lane & 31, kc = lane >> 5; const float cm = cmv[n], inv = cm > 0.f ? 127.0f / cm : 0.f;
#pragma unroll 2
    for (int it = 0; it < 8; ++it) { const int ch = (it * 8 + wave) * 2 + kc;
        const LAS bf16* s = (const LAS bf16*)(img + ch * 1088) + n;
        unsigned o[4];
#pragma unroll
        for (int q = 0; q < 4; ++q) o[q] = q8(bf1(s[(4 * q) * 32]) * inv) | (q8(bf1(s[(4 * q + 1) * 32]) * inv) << 8) | (q8(bf1(s[(4 * q + 2) * 32]) * inv) << 16) | (q8(bf1(s[(4 * q + 3) * 32]) * inv) << 24);
        *(v4u*)(W8row0 + (size_t)n * 4096 + kbase + ch * 16) = (v4u){o[0], o[1], o[2], o[3]}; }
}
__device__ __forceinline__ void quantize_cols32_wg(Frame& F, const float* W, int N, const float* gk, signed char* W8, float* sw, int nblocks, int skip_from, int skip_cnt, int pad_from, int rank, int nrank, unsigned* dyn = nullptr) {
    const int lane = F.lane, wave = F.wave, r8 = lane >> 3, c8 = lane & 7;
    LAS unsigned char* img = F.lds + RING_OFF; LAS float* red = (LAS float*)(F.lds + RING_OFF + 139264); LAS float* cmv = red + 8 * 32;
    LAS int* nxt = (LAS int*)(cmv + 32);
    for (int eb = rank; ; eb += nrank) {
        if (dyn) { if (F.tid == 0) *nxt = (int)atomicAdd(dyn, 1u); WG_BAR_LDS(); eb = *nxt; }
        if (eb >= nblocks) break;
        const int b32 = eb < skip_from ? eb : eb + skip_cnt, n0 = b32 * 32, dsh = (n0 >= pad_from) ? 64 : 0;
        const unsigned off0 = ((unsigned)(wave * 8 + r8) * (unsigned)N + (unsigned)(n0 + 4 * c8)) * 4u, step = (unsigned)N * 256u;
        f32x4 m = (f32x4){0.f, 0.f, 0.f, 0.f};
#pragma unroll 1
        for (int hb = 0; hb < 2; ++hb) { f32x4 v[16];
#pragma unroll
            for (int i = 0; i < 16; ++i) v[i] = *(const f32x4*)((const char*)W + (off0 + (unsigned)(hb * 16 + i) * step));
#pragma unroll
            for (int i = 0; i < 16; ++i) { const int lr = (hb * 16 + i) * 64 + wave * 8 + r8; const float g = gk ? gk[lr] : 1.0f; const f32x4 x = v[i] * g;
                m.x = fmaxf(m.x, fabsf(x.x)); m.y = fmaxf(m.y, fabsf(x.y)); m.z = fmaxf(m.z, fabsf(x.z)); m.w = fmaxf(m.w, fabsf(x.w));
                v2u w; w.x = pk2(x.x, x.y); w.y = pk2(x.z, x.w); *(LAS v2u*)(img + lr * 64 + (lr >> 4) * 64 + c8 * 8) = w; } }
#pragma unroll 1
        for (int hb = 0; hb < 2; ++hb) { f32x4 v[16];
#pragma unroll
            for (int i = 0; i < 16; ++i) v[i] = *(const f32x4*)((const char*)W + (off0 + (unsigned)(32 + hb * 16 + i) * step));
#pragma unroll
            for (int i = 0; i < 16; ++i) { const int lr = (hb * 16 + i) * 64 + wave * 8 + r8; const float g = gk ? gk[2048 + lr] : 1.0f; const f32x4 x = v[i] * g;
                m.x = fmaxf(m.x, fabsf(x.x)); m.y = fmaxf(m.y, fabsf(x.y)); m.z = fmaxf(m.z, fabsf(x.z)); m.w = fmaxf(m.w, fabsf(x.w)); } }
#pragma unroll
        for (int e = 0; e < 4; ++e) { float v = m[e]; v = fmaxf(v, __shfl_xor(v, 8)); v = fmaxf(v, __shfl_xor(v, 16)); v = fmaxf(v, __shfl_xor(v, 32)); m[e] = v; }
        if (r8 == 0) *(LAS f32x4*)(red + wave * 32 + 4 * c8) = m;
        WG_BAR_LDS();
        if (F.tid < 32) { float v = red[F.tid];
#pragma unroll
            for (int w = 1; w < NWAVES; ++w) v = fmaxf(v, red[w * 32 + F.tid]);
            cmv[F.tid] = v; sw[n0 + F.tid + dsh] = v * (1.0f / 127.0f); }
        WG_BAR_LDS();
        signed char* row0 = W8 + (size_t)(n0 + dsh) * 4096;
        q32_pass2(img, cmv, row0, 0, wave, lane);
        WG_BAR_LDS();
#pragma unroll 1
        for (int hb = 0; hb < 2; ++hb) { f32x4 v[16];
#pragma unroll
            for (int i = 0; i < 16; ++i) v[i] = *(const f32x4*)((const char*)W + (off0 + (unsigned)(32 + hb * 16 + i) * step));
#pragma unroll
            for (int i = 0; i < 16; ++i) { const int lr = (hb * 16 + i) * 64 + wave * 8 + r8; const float g = gk ? gk[2048 + lr] : 1.0f; const f32x4 x = v[i] * g;
                v2u w; w.x = pk2(x.x, x.y); w.y = pk2(x.z, x.w); *(LAS v2u*)(img + lr * 64 + (lr >> 4) * 64 + c8 * 8) = w; } }
        WG_BAR_LDS();
        q32_pass2(img, cmv, row0, 2048, wave, lane);
        WG_BAR_LDS();
    }
}
__device__ __forceinline__ void rows_bf16_to_i8(Frame& F, const bf16* XBp, const unsigned* rmax, unsigned* X8, float* sx, int pitch4 = D / 4) {
    const int gw = F.vcu * NWAVES + F.wave, NGW = F.G * NWAVES, lane = F.lane;
    v4u w[8], wn[8]; unsigned rb = 0, rbn = 0;
    int m = gw;
    if (m < M) { const v4u* src = (const v4u*)(XBp + (size_t)m * D) + lane; rb = rmax[m];
#pragma unroll
        for (int j = 0; j < 8; ++j) w[j] = src[64 * j]; }
    for (; m < M; m += NGW) {
        const int mn = m + NGW;
        if (mn < M) { const v4u* src = (const v4u*)(XBp + (size_t)mn * D) + lane; rbn = rmax[mn];
#pragma unroll
            for (int j = 0; j < 8; ++j) wn[j] = src[64 * j]; }
        const float mx = __builtin_bit_cast(float, rb), inv = mx > 0.f ? 127.0f / mx : 0.f;
        v2u* dst = (v2u*)(X8 + (size_t)m * pitch4) + lane;
#pragma unroll
        for (int j = 0; j < 8; ++j) { v2u o;
            o.x = q8(blo(w[j].x) * inv) | (q8(bhi(w[j].x) * inv) << 8) | (q8(blo(w[j].y) * inv) << 16) | (q8(bhi(w[j].y) * inv) << 24);
            o.y = q8(blo(w[j].z) * inv) | (q8(bhi(w[j].z) * inv) << 8) | (q8(blo(w[j].w) * inv) << 16) | (q8(bhi(w[j].w) * inv) << 24);
            dst[64 * j] = o; }
        if (lane == 0) sx[m] = mx * (1.0f / 127.0f);
#pragma unroll
        for (int j = 0; j < 8; ++j) w[j] = wn[j];
        rb = rbn;
    }
}
struct RowTile { f32x4 v[16]; };
__device__ __forceinline__ void row_load(RowTile& R, const float* xrow, int lane) {
    const f32x4* xr = (const f32x4*)xrow + lane;
#pragma unroll
    for (int j = 0; j < 16; ++j) R.v[j] = __builtin_nontemporal_load(xr + 64 * j);
}
__device__ __forceinline__ void row_store(const RowTile& R, bf16* orow, float* rstd_out, unsigned* q8row, float* sx_out, int lane) {
    float s = 0.f, mx = 0.f;
#pragma unroll
    for (int j = 0; j < 16; ++j) { s += (R.v[j].x * R.v[j].x + R.v[j].y * R.v[j].y) + (R.v[j].z * R.v[j].z + R.v[j].w * R.v[j].w);
        mx = fmaxf(fmaxf(mx, fmaxf(fabsf(R.v[j].x), fabsf(R.v[j].y))), fmaxf(fabsf(R.v[j].z), fabsf(R.v[j].w))); }
    s = wave_sum(s);
    if (orow) { v2u* o8 = (v2u*)orow + lane;
#pragma unroll
        for (int j = 0; j < 16; ++j) { v2u w; w.x = pk2(R.v[j].x, R.v[j].y); w.y = pk2(R.v[j].z, R.v[j].w); o8[64 * j] = w; } }
    if (q8row) {
#pragma unroll
        for (int o = 1; o < 64; o <<= 1) mx = fmaxf(mx, __shfl_xor(mx, o));
        const float inv = mx > 0.f ? 127.0f / mx : 0.f;
#pragma unroll
        for (int j = 0; j < 16; ++j) q8row[lane + 64 * j] = q8(R.v[j].x * inv) | (q8(R.v[j].y * inv) << 8) | (q8(R.v[j].z * inv) << 16) | (q8(R.v[j].w * inv) << 24);
        if (lane == 0) *sx_out = mx * (1.0f / 127.0f);
    }
    if (lane == 0) *rstd_out = 1.0f / sqrtf(s * (1.0f / 4096.0f) + 1e-6f);
}
__device__ __forceinline__ void rows_to_bf16_rstd(Frame& F, const float* X, bf16* XB, float* rstd, unsigned* X8, float* sx) {
    const int gw = F.vcu * NWAVES + F.wave, NGW = F.G * NWAVES;
    RowTile A, B; int m = gw;
    if (m < M) row_load(A, X + (size_t)m * D, F.lane);
    while (m < M) {
        const int mb = m + NGW;
        if (mb < M) row_load(B, X + (size_t)mb * D, F.lane);
        row_store(A, XB ? XB + (size_t)m * D : nullptr, rstd + m, X8 ? X8 + (size_t)m * (D / 4) : nullptr, sx + m, F.lane);
        if (mb >= M) break;
        m = mb + NGW;
        if (m < M) row_load(A, X + (size_t)m * D, F.lane);
        row_store(B, XB ? XB + (size_t)mb * D : nullptr, rstd + mb, X8 ? X8 + (size_t)mb * (D / 4) : nullptr, sx + mb, F.lane);
    }
}

__device__ __forceinline__ void p_prologue(Frame& F) {
    unsigned char* ws = F.ws;
    int rq = F.vcu, nq = F.G, rc = F.vcu, nc = F.G;
    if (F.G == 256) { const int xl = F.vcu & 31, xq = F.vcu >> 5; if (xl < 25) { rq = xq * 25 + xl; nq = 200; rc = -1; } else { rc = xq * 7 + (xl - 25); nc = 56; rq = -1; } }
    if (rq >= 0) quantize_cols32_wg(F, F.in[3], NIN, F.in[2], (signed char*)(ws + WS_WIN8), (float*)(ws + WS_SW), 400, 144, 206, 11200, rq, nq);
    if (rc >= 0) {
        colmax_sweep(F, F.in[20], D, D, nullptr, (unsigned*)(ws + CTL_CMAXO), 1 << 30, 0, 1 << 30, rc, nc);
        colmax_sweep(F, F.in[25], D, D, F.in[24], (unsigned*)(ws + CTL_CMAXP), 1 << 30, 0, 1 << 30, rc, nc);
    }
    __syncthreads();
    rows_to_bf16_rstd(F, F.in[0], (bf16*)(ws + WS_XB), (float*)(ws + WS_RSTD), (unsigned*)(ws + WS_X8), (float*)(ws + WS_SX));
    { const size_t gt0 = (size_t)blockIdx.x * 512 + F.tid, NT0 = (size_t)F.G * 512;
      v4u* z = (v4u*)(ws + WS_WIN8 + (size_t)11200 * D); for (size_t i = gt0; i < (size_t)64 * D / 16; i += NT0) z[i] = (v4u){0u, 0u, 0u, 0u};
      if (gt0 < 64) ((float*)(ws + WS_SW))[11200 + gt0] = 0.f; }
    transpose_matrix(F, F.in[3], D, NIN, (bf16*)(ws + WS_WZT) - (size_t)4608 * D, F.in[2], 1 << 30, 0, 72, 103);
    { const size_t gt0 = (size_t)blockIdx.x * 512 + F.tid, NT0 = (size_t)F.G * 512; v4u* z = (v4u*)(ws + WS_WZT + (size_t)6592 * D * 2); for (size_t i = gt0; i < (size_t)64 * D / 8; i += NT0) z[i] = (v4u){0u, 0u, 0u, 0u}; }
    __syncthreads();
    const size_t gt = (size_t)blockIdx.x * 512 + F.tid, NT = (size_t)F.G * 512;
    {
        const float* wd = F.in[10]; const float* wa = F.in[12]; const float* wg = F.in[13]; bf16* WL = (bf16*)(ws + WS_WLORA);
        for (size_t i = gt; i < (size_t)LORAN * 64; i += NT) { const int n = (int)(i % LORAN), k8 = (int)(i / LORAN) * 8, third = n >> 11, c = n & 2047; float v[8];
#pragma unroll
            for (int j = 0; j < 8; ++j) { const int k = k8 + j; float x = 0.f;
                if (third == 0) { if (k < 96) x = wd[(size_t)k * 2048 + c]; }
                else if (third == 1) { if (k >= 96 && k < 192) x = wa[(size_t)(k - 96) * 2048 + c]; }
                else { if (k >= 192 && k < 448) x = wg[(size_t)(k - 192) * 2048 + c]; }
                v[j] = x; }
            v4u o; o.x = pk2(v[0], v[1]); o.y = pk2(v[2], v[3]); o.z = pk2(v[4], v[5]); o.w = pk2(v[6], v[7]);
            *(v4u*)(WL + (size_t)n * LORAK + k8) = o; } }
}

__device__ __forceinline__ void late_conversions(Frame& F, int rank, int nrank) {
    unsigned char* ws = F.ws;
    transpose_matrix(F, F.in[7], AOW, D, (bf16*)(ws + WS_WATT), nullptr, 1 << 30, 0, 0, -1, rank, nrank);
    transpose_matrix(F, F.in[19], RWW, D, (bf16*)(ws + WS_WRW), nullptr, 1 << 30, 0, 0, -1, rank, nrank);
    const size_t gt = (size_t)rank * 512 + F.tid, NT = (size_t)nrank * 512;
    const f32x4* p4 = (const f32x4*)F.in[1]; v2u* pb = (v2u*)(ws + WS_PB);
    for (size_t i = gt; i < (size_t)M * PLE / 4; i += NT) { const f32x4 v = p4[i]; v2u w; w.x = pk2(v.x, v.y); w.y = pk2(v.z, v.w); pb[i] = w; }
}
__device__ __forceinline__ void t_lora_in(Frame& F) {
    unsigned char* ws = F.ws;
    const bf16* Z = (const bf16*)(ws + WS_Z); bf16* AL = (bf16*)(ws + WS_ALORA);
    const float* mix = F.in[8];
    const int gw = F.vcu * NWAVES + F.wave, NGW = F.G * NWAVES, lane = F.lane;
    const int c = lane * 8; const bool act = lane < 56;
    float mx[8];
#pragma unroll
    for (int j = 0; j < 8; ++j) mx[j] = act ? mix[6144 + c + j] : 0.f;
    v4u w = (v4u){0u, 0u, 0u, 0u}, wp = w, wn = w, wpn = w;
    int m = gw;
    if (m < M && act) { w = *(const v4u*)(Z + (size_t)m * NZP + 6144 + c); if ((m & (SEQ - 1)) != 0) wp = *(const v4u*)(Z + (size_t)(m - 1) * NZP + 6144 + c); }
    for (; m < M; m += NGW) {
        const int mn = m + NGW;
        wn = (v4u){0u, 0u, 0u, 0u}; wpn = wn;
        if (mn < M && act) { wn = *(const v4u*)(Z + (size_t)mn * NZP + 6144 + c); if ((mn & (SEQ - 1)) != 0) wpn = *(const v4u*)(Z + (size_t)(mn - 1) * NZP + 6144 + c); }
        v4u o = (v4u){0u, 0u, 0u, 0u};
        if (act) {
            float v[8] = {blo(w.x), bhi(w.x), blo(w.y), bhi(w.y), blo(w.z), bhi(w.z), blo(w.w), bhi(w.w)};
            const float vp[8] = {blo(wp.x), bhi(wp.x), blo(wp.y), bhi(wp.y), blo(wp.z), bhi(wp.z), blo(wp.w), bhi(wp.w)};
#pragma unroll
            for (int j = 0; j < 8; ++j) { float z = v[j] + mx[j] * (vp[j] - v[j]);
                if (c < 96) z = 1.0f - 2.0f / (1.0f + __expf(2.0f * z)); else if (c >= 192) z = 1.0f / (1.0f + __expf(-z));
                v[j] = z; }
            o.x = pk2(v[0], v[1]); o.y = pk2(v[2], v[3]); o.z = pk2(v[4], v[5]); o.w = pk2(v[6], v[7]); }
        *(v4u*)(AL + (size_t)m * LORAK + lane * 8) = o;
        w = wn; wp = wpn;
    }
    __syncthreads();
    quantize_cols32_wg(F, F.in[22], DFF, F.in[21], (signed char*)(ws + WS_W8M), (float*)(ws + WS_SWM), DFF / 32, 1 << 30, 0, 1 << 30, F.vcu, F.G);
    quantize_matrix(F, F.in[20], D, D, (signed char*)(ws + WS_W8O), nullptr, (const unsigned*)(ws + CTL_CMAXO), (float*)(ws + WS_SWO), 1 << 30, 0, 1 << 30);
}

__device__ __forceinline__ float t5_bias_bucket(int dist) {
    if (dist < 16) return (float)dist;
    int l = 16 + (int)(logf((float)dist / 16.0f) / 4.852030263919617f * 16.0f); return (float)(l < 31 ? l : 31);
}
constexpr int KL_STRIDE = 272, VT_STRIDE = 520, KL_BYTES = 256 * KL_STRIDE, VT_BYTES = 128 * VT_STRIDE, BT_OFF = KL_BYTES + VT_BYTES;
__device__ __forceinline__ void t_attn(Frame& F) {
    typedef short bf16x8 __attribute__((ext_vector_type(8)));
    unsigned char* ws = F.ws;
    const bf16* QKV = (const bf16*)(ws + WS_QKV); bf16* OG = (bf16*)(ws + WS_OG); float* LSE = (float*)(ws + WS_LSE); const float* relb = F.in[6];
    LAS unsigned char* KL = F.lds + RING_OFF; LAS unsigned char* VT = KL + KL_BYTES; LAS float* btab = (LAS float*)(KL + BT_OFF);
    for (int i = F.tid; i < 12 * 132; i += 512) { const int hh = i / 132, j = i % 132, gi = hh >> 2; float bb = 0.f;
        if (j <= 128) { const int bk = (int)t5_bias_bucket(j << (2 * gi)); bb = relb[bk * 12 + hh]; }
        btab[i] = bb; }
    const int tid = F.tid, lane = F.lane, w = F.wave, n = lane & 15, g = lane >> 4;
    const float SC = 0.08838834764831845f;
    const float* qgp = F.in[4];
    float kgn[8];
#pragma unroll
    for (int j = 0; j < 8; ++j) kgn[j] = F.in[5][8 * (tid & 15) + j];
    v4u kreg[8], vreg0[4], vreg1[4], qreg[4];
#define ATTN_LOAD(unit_) do { const int b_ = (unit_) / 384, rem_ = (unit_) % 384, h_ = rem_ >> 5, x_ = rem_ & 31, dl_ = 2 * (h_ >> 2), d_ = 1 << dl_, nbc_ = 32 >> dl_, r_ = x_ / nbc_, nb_ = x_ % nbc_; const size_t rowb_ = (size_t)b_ * SEQ; \
        _Pragma("unroll") for (int q_ = 0; q_ < 8; ++q_) { const int idx_ = tid + 512 * q_, key_ = idx_ >> 4, dch_ = idx_ & 15, ci_ = (nb_ - 1) * 128 + key_; kreg[q_] = (v4u){0u, 0u, 0u, 0u}; \
            if (ci_ >= 0) kreg[q_] = *(const v4u*)(QKV + (rowb_ + (size_t)(ci_ * d_ + r_)) * NQKV + 1536 + h_ * 128 + 8 * dch_); } \
        _Pragma("unroll") for (int q_ = 0; q_ < 4; ++q_) { const int idx_ = tid + 512 * q_, kp_ = idx_ >> 4, dch_ = idx_ & 15, ci_ = (nb_ - 1) * 128 + 2 * kp_; vreg0[q_] = (v4u){0u, 0u, 0u, 0u}; vreg1[q_] = vreg0[q_]; \
            if (ci_ >= 0) { const bf16* vp_ = QKV + (rowb_ + (size_t)(ci_ * d_ + r_)) * NQKV + 3072 + h_ * 128 + 8 * dch_; vreg0[q_] = *(const v4u*)vp_; vreg1[q_] = *(const v4u*)(vp_ + (size_t)d_ * NQKV); } } \
        { const size_t rowq_ = rowb_ + (size_t)((nb_ * 128 + 16 * w + n) * d_ + r_); \
        _Pragma("unroll") for (int ks_ = 0; ks_ < 4; ++ks_) qreg[ks_] = *(const v4u*)(QKV + rowq_ * NQKV + h_ * 128 + 32 * ks_ + 8 * g); } } while (0)
    if ((int)blockIdx.x < 1536) ATTN_LOAD((int)blockIdx.x);
    for (int unit = blockIdx.x; unit < 1536; unit += F.G) {
        const int b = unit / 384, rem = unit % 384, h = rem >> 5, x = rem & 31, gi = h >> 2, dl = 2 * gi, d = 1 << dl, nbc = 32 >> dl, r = x / nbc, nb = x % nbc;
        const size_t rowb = (size_t)b * SEQ;
        WG_BAR_LDS();
#pragma unroll
        for (int q = 0; q < 8; ++q) { const int idx = tid + 512 * q, key = idx >> 4, dch = idx & 15; const v4u val = kreg[q];
            float kv[8] = {blo(val.x), bhi(val.x), blo(val.y), bhi(val.y), blo(val.z), bhi(val.z), blo(val.w), bhi(val.w)}; float ss = 0.f;
#pragma unroll
            for (int j = 0; j < 8; ++j) ss += kv[j] * kv[j];
            ss += dppf<0xB1>(ss); ss += dppf<0x4E>(ss); ss += dppf<0x141>(ss); ss += dppf<0x140>(ss);
            const float rs = __builtin_amdgcn_rsqf(ss * (1.0f / 128.0f) + 1e-6f);
            v4u o; o.x = pk2(kv[0] * rs * kgn[0], kv[1] * rs * kgn[1]); o.y = pk2(kv[2] * rs * kgn[2], kv[3] * rs * kgn[3]); o.z = pk2(kv[4] * rs * kgn[4], kv[5] * rs * kgn[5]); o.w = pk2(kv[6] * rs * kgn[6], kv[7] * rs * kgn[7]);
            *(LAS v4u*)(KL + key * KL_STRIDE + dch * 16) = o; }
#pragma unroll
        for (int q = 0; q < 4; ++q) { const int idx = tid + 512 * q, kp = idx >> 4, dch = idx & 15; const v4u v0 = vreg0[q], v1 = vreg1[q];
            LAS unsigned char* o = VT + (8 * dch) * VT_STRIDE + 4 * kp;
            *(LAS unsigned*)(o + 0 * VT_STRIDE) = (v0.x & 0xffffu) | (v1.x << 16); *(LAS unsigned*)(o + 1 * VT_STRIDE) = (v0.x >> 16) | (v1.x & 0xffff0000u);
            *(LAS unsigned*)(o + 2 * VT_STRIDE) = (v0.y & 0xffffu) | (v1.y << 16); *(LAS unsigned*)(o + 3 * VT_STRIDE) = (v0.y >> 16) | (v1.y & 0xffff0000u);
            *(LAS unsigned*)(o + 4 * VT_STRIDE) = (v0.z & 0xffffu) | (v1.z << 16); *(LAS unsigned*)(o + 5 * VT_STRIDE) = (v0.z >> 16) | (v1.z & 0xffff0000u);
            *(LAS unsigned*)(o + 6 * VT_STRIDE) = (v0.w & 0xffffu) | (v1.w << 16); *(LAS unsigned*)(o + 7 * VT_STRIDE) = (v0.w >> 16) | (v1.w & 0xffff0000u); }
        const int qi = 16 * w + n; const size_t rowq = rowb + (size_t)((nb * 128 + qi) * d + r);
        bf16x8 qf[4];
        { v4u qr[4]; float qs = 0.f;
#pragma unroll
            for (int ks = 0; ks < 4; ++ks) { qr[ks] = qreg[ks];
                const float a0 = blo(qr[ks].x), a1 = bhi(qr[ks].x), a2 = blo(qr[ks].y), a3 = bhi(qr[ks].y), a4 = blo(qr[ks].z), a5 = bhi(qr[ks].z), a6 = blo(qr[ks].w), a7 = bhi(qr[ks].w);
                qs += (a0 * a0 + a1 * a1) + (a2 * a2 + a3 * a3) + (a4 * a4 + a5 * a5) + (a6 * a6 + a7 * a7); }
            qs += __shfl_xor(qs, 16); qs += __shfl_xor(qs, 32);
            const float rs = __builtin_amdgcn_rsqf(qs * (1.0f / 128.0f) + 1e-6f) * SC;
#pragma unroll
            for (int ks = 0; ks < 4; ++ks) { const f32x4 g0 = *(const f32x4*)(qgp + 32 * ks + 8 * g), g1 = *(const f32x4*)(qgp + 32 * ks + 8 * g + 4); u32x4_t w;
                w.x = pk2(blo(qr[ks].x) * rs * g0.x, bhi(qr[ks].x) * rs * g0.y); w.y = pk2(blo(qr[ks].y) * rs * g0.z, bhi(qr[ks].y) * rs * g0.w);
                w.z = pk2(blo(qr[ks].z) * rs * g1.x, bhi(qr[ks].z) * rs * g1.y); w.w = pk2(blo(qr[ks].w) * rs * g1.z, bhi(qr[ks].w) * rs * g1.w);
                qf[ks] = __builtin_bit_cast(bf16x8, w); } }
        if (unit + (int)F.G < 1536) ATTN_LOAD(unit + (int)F.G);
        WG_BAR_LDS();
        f32x4 sacc[9];
#pragma unroll
        for (int u = 0; u < 9; ++u) { f32x4 acc = (f32x4){0.f, 0.f, 0.f, 0.f};
#pragma unroll
            for (int ks = 0; ks < 4; ++ks) { const bf16x8 a = *(const LAS bf16x8*)(KL + (16 * (w + u) + n) * KL_STRIDE + (32 * ks + 8 * g) * 2); acc = __builtin_amdgcn_mfma_f32_16x16x32_bf16(a, qf[ks], acc, 0, 0, 0); }
            sacc[u] = acc; }
        const LAS float* bt = btab + h * 132; float mx = -1e30f;
#pragma unroll
        for (int u = 0; u < 9; ++u)
#pragma unroll
            for (int i = 0; i < 4; ++i) { const int rel = 128 + n - 16 * u - 4 * g - i, kj = 16 * (w + u) + 4 * g + i; const bool ok = rel >= 0 && rel <= 128 && (nb > 0 || kj >= 128);
                const float sv = ok ? sacc[u][i] + bt[rel < 0 ? 0 : (rel > 128 ? 128 : rel)] : -1e30f; sacc[u][i] = sv; mx = fmaxf(mx, sv); }
        mx = fmaxf(mx, __shfl_xor(mx, 16)); mx = fmaxf(mx, __shfl_xor(mx, 32));
        float l = 0.f;
#pragma unroll
        for (int u = 0; u < 9; ++u)
#pragma unroll
            for (int i = 0; i < 4; ++i) { const float p = __expf(sacc[u][i] - mx); sacc[u][i] = p; l += p; }
        l += __shfl_xor(l, 16); l += __shfl_xor(l, 32);
        f32x4 oacc[8];
#pragma unroll
        for (int dt = 0; dt < 8; ++dt) oacc[dt] = (f32x4){0.f, 0.f, 0.f, 0.f};
#pragma unroll
        for (int blk = 0; blk < 5; ++blk) { const int u0 = 2 * blk, u1 = (2 * blk + 1 < 9) ? 2 * blk + 1 : u0;
            u32x4_t pw; pw.x = pg8::cvt_pk_bf16(sacc[u0][0], sacc[u0][1]); pw.y = pg8::cvt_pk_bf16(sacc[u0][2], sacc[u0][3]);
            if (2 * blk + 1 < 9) { pw.z = pg8::cvt_pk_bf16(sacc[u1][0], sacc[u1][1]); pw.w = pg8::cvt_pk_bf16(sacc[u1][2], sacc[u1][3]); } else { pw.z = 0u; pw.w = 0u; }
            const bf16x8 pf = __builtin_bit_cast(bf16x8, pw);
#pragma unroll
            for (int dt = 0; dt < 8; ++dt) { const LAS unsigned char* vr = VT + (16 * dt + n) * VT_STRIDE + 8 * g;
                const v2u lo = *(const LAS v2u*)(vr + 32 * (w + u0)), hi = *(const LAS v2u*)(vr + 32 * (w + u1));
                u32x4_t aw; aw.x = lo.x; aw.y = lo.y; aw.z = hi.x; aw.w = hi.y;
                oacc[dt] = __builtin_amdgcn_mfma_f32_16x16x32_bf16(__builtin_bit_cast(bf16x8, aw), pf, oacc[dt], 0, 0, 0); } }
        const float inv = 1.0f / l; bf16* op = OG + rowq * 1536 + h * 128 + 4 * g;
#pragma unroll
        for (int dt = 0; dt < 8; ++dt) { v2u o; o.x = pk2(oacc[dt][0] * inv, oacc[dt][1] * inv); o.y = pk2(oacc[dt][2] * inv, oacc[dt][3] * inv); *(v2u*)(op + 16 * dt) = o; }
        if (g == 0) LSE[rowq * 12 + h] = mx + __logf(l);
    }
}
__device__ __forceinline__ void attn_merge(Frame& F) {
    unsigned char* ws = F.ws;
    const bf16* OG = (const bf16*)(ws + WS_OG); const float* LSE = (const float*)(ws + WS_LSE); bf16* ATT = (bf16*)(ws + WS_ATT);
    const int gw = F.vcu * NWAVES + F.wave, NGW = F.G * NWAVES, lane = F.lane;
    for (int it = gw; it < M * 4; it += NGW) { const int m = it >> 2, hg = it & 3;
        const float l0 = LSE[(size_t)m * 12 + hg], l1 = LSE[(size_t)m * 12 + 4 + hg], l2 = LSE[(size_t)m * 12 + 8 + hg], mx = fmaxf(l0, fmaxf(l1, l2));
        const float e0 = __expf(l0 - mx), e1 = __expf(l1 - mx), e2 = __expf(l2 - mx), inv = 1.0f / (e0 + e1 + e2);
        const bf16* op = OG + (size_t)m * 1536 + hg * 128 + 2 * lane;
        const unsigned a = *(const unsigned*)op, bq = *(const unsigned*)(op + 512), c = *(const unsigned*)(op + 1024);
        *(unsigned*)(ATT + (size_t)m * AOW + hg * 128 + 2 * lane) = pk2((e0 * blo(a) + e1 * blo(bq) + e2 * blo(c)) * inv, (e0 * bhi(a) + e1 * bhi(bq) + e2 * bhi(c)) * inv); }
}

constexpr int NCH = 8, CHL = SEQ / NCH, TBK = 8, STEPF = 384;
struct ScanRaw { float r[5], k[5], v[5], e[4], a[4]; };
__device__ __forceinline__ void scan_load_raw(ScanRaw& R, const bf16* Z, const bf16* EAG, size_t row0, int t0, int c) {
#pragma unroll
    for (int i = 0; i < 5; ++i) { const bool ok = (i > 0) || (t0 > 0); const bf16* zr = Z + (row0 + i - 1) * NZP;
        R.r[i] = ok ? bf1(zr[c]) : 0.f; R.k[i] = ok ? bf1(zr[2048 + c]) : 0.f; R.v[i] = ok ? bf1(zr[4096 + c]) : 0.f; }
#pragma unroll
    for (int i = 0; i < 4; ++i) { R.e[i] = bf1(EAG[(row0 + i) * 2048 + c]); R.a[i] = bf1(EAG[(size_t)M * 2048 + (row0 + i) * 2048 + c]); }
}
__device__ __forceinline__ void scan_prep4(const ScanRaw& R, LAS float* rec  , float* rkb  , int lane,
                                           float mr, float mk, float mv, float kkc, float kac, float rkc) {
#pragma unroll
    for (int i = 0; i < 4; ++i) {
        const float r = R.r[i + 1] + mr * (R.r[i] - R.r[i + 1]), k = R.k[i + 1] + mk * (R.k[i] - R.k[i + 1]), v = R.v[i + 1] + mv * (R.v[i] - R.v[i + 1]);
        const float decay = __expf(-R.e[i]), a = R.a[i];
        const float kkj = k * kkc, n2 = wave_sum_dpp(kkj * kkj), kk = kkj * __builtin_amdgcn_rsqf(fmaxf(n2, 1e-24f));
        const float kp = k * (1.0f + (a - 1.0f) * kac);
        const float rks = wave_sum_dpp(r * kp * rkc);
        LAS float* o = rec + i * STEPF + lane;
        o[0] = -kk; o[64] = decay; o[128] = kk * a; o[192] = kp; o[256] = r; o[320] = v;
        if (lane == 0) rkb[i * 32] = rks;
    }
}
typedef float f2 __attribute__((ext_vector_type(2)));
struct St { f2 v[8][4]; };
template <bool IS_S> __device__ __forceinline__ void scan_step(St& S, const LAS float* rec, int rg, int cg, float* yout, bool writer) {
    const LAS f32x4* p = (const LAS f32x4*)rec + cg * 2;
    const f32x4 a0 = p[0], a1 = p[1], w0 = p[16], w1 = p[17], b0 = p[32], b1 = p[33], r0 = p[64], r1 = p[65];
    const f2 a[4] = {a0.xy, a0.zw, a1.xy, a1.zw}, w[4] = {w0.xy, w0.zw, w1.xy, w1.zw}, b[4] = {b0.xy, b0.zw, b1.xy, b1.zw}, rr[4] = {r0.xy, r0.zw, r1.xy, r1.zw};
    float sa[8];
#pragma unroll
    for (int r = 0; r < 8; ++r) { f2 s = S.v[r][0] * a[0]; s = S.v[r][1] * a[1] + s; s = S.v[r][2] * a[2] + s; s = S.v[r][3] * a[3] + s; sa[r] = s.x + s.y; }
#pragma unroll
    for (int r = 0; r < 8; ++r) sa[r] = red8(sa[r]);
    if (IS_S) {
        const f32x4 k0 = p[48], k1 = p[49]; const LAS f32x4* pv = (const LAS f32x4*)rec + 80 + rg * 2; const f32x4 v0 = pv[0], v1 = pv[1];
        const f2 k[4] = {k0.xy, k0.zw, k1.xy, k1.zw}; const float v[8] = {v0.x, v0.y, v0.z, v0.w, v1.x, v1.y, v1.z, v1.w};
#pragma unroll
        for (int r = 0; r < 8; ++r) { const f2 sr = (f2){sa[r], sa[r]}, vr = (f2){v[r], v[r]};
#pragma unroll
            for (int q = 0; q < 4; ++q) { f2 t = S.v[r][q] * w[q]; t = sr * b[q] + t; S.v[r][q] = vr * k[q] + t; } }
    } else {
#pragma unroll
        for (int r = 0; r < 8; ++r) { const f2 sr = (f2){sa[r], sa[r]};
#pragma unroll
            for (int q = 0; q < 4; ++q) { const f2 t = S.v[r][q] * w[q]; S.v[r][q] = sr * b[q] + t; } }
    }
    float y[8];
#pragma unroll
    for (int r = 0; r < 8; ++r) { f2 s = S.v[r][0] * rr[0]; s = S.v[r][1] * rr[1] + s; s = S.v[r][2] * rr[2] + s; s = S.v[r][3] * rr[3] + s; y[r] = s.x + s.y; }
#pragma unroll
    for (int r = 0; r < 8; ++r) y[r] = red8(y[r]);
    if (writer) { if (IS_S) { f32x4* yo = (f32x4*)yout; yo[0] = (f32x4){y[0], y[1], y[2], y[3]}; yo[1] = (f32x4){y[4], y[5], y[6], y[7]}; }
                  else { v4u o; o.x = pk2(y[0], y[1]); o.y = pk2(y[2], y[3]); o.z = pk2(y[4], y[5]); o.w = pk2(y[6], y[7]); *(v4u*)yout = o; } }
}
constexpr int SC_RM = 144;
constexpr int SC_TR = 40;
constexpr int SC_AT = 0, SC_RT = 2304, SC_BT = 4608, SC_KT = 6912, SC_W = 9216, SC_ATT = 11520, SC_BHT = 14080, SC_KHT = 16640, SC_VT = 19200, SC_GC = 21760, SC_L = 22016, SC_T = 23040,
              SC_AAK = 23552, SC_ARB = 24064, SC_ARK = 24576, SC_RAW = 25088, SC_WAVE = 35328;
typedef short bf16x8s __attribute__((ext_vector_type(8)));
__device__ __forceinline__ bf16x8s mk8(v2u lo, v2u hi) { u32x4_t w; w.x = lo.x; w.y = lo.y; w.z = hi.x; w.w = hi.y; return __builtin_bit_cast(bf16x8s, w); }
__device__ __forceinline__ v2u pk4(const f32x4 v) { v2u w; w.x = pg8::cvt_pk_bf16_n(v.x, v.y); w.y = pg8::cvt_pk_bf16_n(v.z, v.w); return w; }
#define SC_MFMA(a, b, c) __builtin_amdgcn_mfma_f32_16x16x32_bf16((a), (b), (c), 0, 0, 0)
#define SC_BAR() do { asm volatile("s_waitcnt lgkmcnt(0)" ::: "memory"); __builtin_amdgcn_s_barrier(); asm volatile("" ::: "memory"); } while (0)
__device__ __forceinline__ void t_scan1(Frame& F) {
    unsigned char* ws = F.ws;
    const bf16* Z = (const bf16*)(ws + WS_Z); const bf16* EAG = (const bf16*)(ws + WS_EAG);
    bf16* YLOC = (bf16*)(ws + WS_YLOC); bf16* GBUF = (bf16*)(ws + WS_GBUF); float* LST = (float*)(ws + WS_LST); float* TST = (float*)(ws + WS_TST); float* RKB = (float*)(ws + WS_RKB);
    const float* mix = F.in[8]; const float* k_k = F.in[14]; const float* k_a = F.in[15]; const float* r_k = F.in[16];
    const int lane = F.lane, wave = F.wave, pr = wave & 3, n = lane & 15, q = lane >> 4;
    const bool isT = wave >= 4;
    LAS unsigned char* WB = F.lds + RING_OFF + pr * SC_WAVE;
    const v2u z2 = (v2u){0u, 0u};
    for (int wi = blockIdx.x; wi < 128 * NCH / 4; wi += F.G) {
        const int pair = wi * 4 + pr, unit = pair / NCH, ch = pair % NCH, b = unit >> 5, h = unit & 31, c = h * 64 + lane;
        const size_t rowc = (size_t)b * SEQ + (size_t)ch * CHL;
        const int tc = ch * CHL;
        const bool phi_on = ch > 0;
        f32x4 acc[4][4];
#pragma unroll
        for (int jt = 0; jt < 4; ++jt)
#pragma unroll
            for (int it = 0; it < 4; ++it)
#pragma unroll
                for (int r = 0; r < 4; ++r) acc[jt][it][r] = (isT && jt == it && 4 * q + r == n) ? 1.f : 0.f;
        const float mr = mix[c], mk = mix[2048 + c], mv = mix[4096 + c], kkc = k_k[c], kac = k_a[c], rkc = r_k[c];
        v4u raw[5];
        const int hf = isT ? 1 : 0;
        const unsigned lo_z = (unsigned)(lane >> 3) * (NZP * 2) + (unsigned)(lane & 7) * 16, lo_e = (unsigned)(lane >> 3) * 4096 + (unsigned)(lane & 7) * 16, lo_l = (unsigned)(lane >> 3) * 640 + (unsigned)(lane & 7) * 16;
        { const char* zb = (const char*)(Z + (rowc + 8 * hf) * NZP + h * 64); const char* eb = (const char*)(EAG + (rowc + 8 * hf) * 2048 + h * 64);
#pragma unroll
            for (int i = 0; i < 5; ++i) raw[i] = i < 3 ? *(const v4u*)(zb + i * 4096 + lo_z) : *(const v4u*)(eb + (size_t)(i - 3) * M * 4096 + lo_e); }
        bf16 pz0 = 0, pz1 = 0, pz2 = 0;
        if (!isT && tc > 0) { const bf16* zp = Z + (rowc - 1) * NZP; pz0 = zp[c]; pz1 = zp[2048 + c]; pz2 = zp[4096 + c]; }
#pragma unroll 1
        for (int sc = 0; sc < CHL / 16; ++sc) {
            const size_t rows = rowc + (size_t)sc * 16;
            {
#pragma unroll
                for (int i = 0; i < 5; ++i) *(LAS v4u*)(WB + SC_RAW + hf * 8 * 640 + i * 128 + lo_l) = raw[i];
                float pzr = bf1(pz0), pzk = bf1(pz1), pzv = bf1(pz2);
                if (sc + 1 < CHL / 16) { const char* zb = (const char*)(Z + (rows + 16 + 8 * hf) * NZP + h * 64); const char* eb = (const char*)(EAG + (rows + 16 + 8 * hf) * 2048 + h * 64);
#pragma unroll
                    for (int i = 0; i < 5; ++i) raw[i] = i < 3 ? *(const v4u*)(zb + i * 4096 + lo_z) : *(const v4u*)(eb + (size_t)(i - 3) * M * 4096 + lo_e);
                    if (!isT) { const bf16* zp = Z + (rows + 15) * NZP; pz0 = zp[c]; pz1 = zp[2048 + c]; pz2 = zp[4096 + c]; } }
                SC_BAR();
                const LAS bf16* RAWL = (const LAS bf16*)(WB + SC_RAW);
                float E2C = 0.f, E2 = 0.f;
#pragma unroll
                for (int t = 0; t < 16; ++t) { const float e2 = bf1(RAWL[t * 320 + 192 + lane]) * 1.4426950408889634f; E2C += e2; if (t < 8) E2 += e2; }
                float gprev = 1.f;
                if (isT) { gprev = __builtin_amdgcn_exp2f(-E2); pzr = bf1(RAWL[7 * 320 + lane]); pzk = bf1(RAWL[7 * 320 + 64 + lane]); pzv = bf1(RAWL[7 * 320 + 128 + lane]); } else E2 = 0.f;
#pragma unroll 1
                for (int qh = 0; qh < 2; ++qh) {
                    const int qt = 2 * hf + qh;
                    unsigned ath[2], bhh[2], khh[2], vth[2];
#pragma unroll
                    for (int tq = 0; tq < 4; ++tq) { const int t = 4 * qt + tq;
                        const float zr = bf1(RAWL[t * 320 + lane]), zk = bf1(RAWL[t * 320 + 64 + lane]), zv = bf1(RAWL[t * 320 + 128 + lane]), e = bf1(RAWL[t * 320 + 192 + lane]), ag = bf1(RAWL[t * 320 + 256 + lane]);
                        const float r = zr + mr * (pzr - zr), k = zk + mk * (pzk - zk), v = zv + mv * (pzv - zv); pzr = zr; pzk = zk; pzv = zv;
                        const float kkj = k * kkc, n2 = wave_sum_dpp(kkj * kkj), kk = kkj * __builtin_amdgcn_rsqf(fmaxf(n2, 1e-24f));
                        const float kp = k * (1.0f + (ag - 1.0f) * kac), bb = kk * ag;
                        const float rks = wave_sum_dpp(r * kp * rkc);
                        if (lane == 0) RKB[(rows + t) * 32 + h] = rks;
                        E2 += e * 1.4426950408889634f;
                        const float gm = __builtin_amdgcn_exp2f(-E2), gi = __builtin_amdgcn_exp2f(E2), gh = __builtin_amdgcn_exp2f(E2 - E2C);
                        const float at = -kk * gprev, rt = r * gm, bt = bb * gi, kt = kp * gi, bh = bb * gh, kh = kp * gh; gprev = gm;
                        LAS bf16* o = (LAS bf16*)(WB + t * SC_RM) + lane;
                        o[SC_AT / 2] = (bf16)f2bf(at); o[SC_RT / 2] = (bf16)f2bf(rt); o[SC_BT / 2] = (bf16)f2bf(bt); o[SC_KT / 2] = (bf16)f2bf(kt);
                        if (tq & 1) { ath[tq >> 1] |= f2bf(at) << 16; bhh[tq >> 1] |= f2bf(bh) << 16; khh[tq >> 1] |= f2bf(kh) << 16; vth[tq >> 1] |= f2bf(v) << 16; }
                        else { ath[tq >> 1] = f2bf(at); bhh[tq >> 1] = f2bf(bh); khh[tq >> 1] = f2bf(kh); vth[tq >> 1] = f2bf(v); }
                    }
                    *(LAS v2u*)(WB + SC_ATT + lane * SC_TR + qt * 8) = (v2u){ath[0], ath[1]}; *(LAS v2u*)(WB + SC_BHT + lane * SC_TR + qt * 8) = (v2u){bhh[0], bhh[1]};
                    *(LAS v2u*)(WB + SC_KHT + lane * SC_TR + qt * 8) = (v2u){khh[0], khh[1]}; *(LAS v2u*)(WB + SC_VT + lane * SC_TR + qt * 8) = (v2u){vth[0], vth[1]};
                }
                if (!isT) ((LAS float*)(WB + SC_GC))[lane] = __builtin_amdgcn_exp2f(-E2C);
            }
            SC_BAR();
            if (!isT) {
                f32x4 mab = (f32x4){0.f, 0.f, 0.f, 0.f}, mak = mab, mrb = mab, mrk = mab;
#pragma unroll
                for (int ks = 0; ks < 2; ++ks) { const int co = (32 * ks + 8 * q) * 2;
                    const bf16x8s fa = *(const LAS bf16x8s*)(WB + SC_AT + n * SC_RM + co), fr = *(const LAS bf16x8s*)(WB + SC_RT + n * SC_RM + co);
                    const bf16x8s fb = *(const LAS bf16x8s*)(WB + SC_BT + n * SC_RM + co), fk = *(const LAS bf16x8s*)(WB + SC_KT + n * SC_RM + co);
                    mab = SC_MFMA(fa, fb, mab); mak = SC_MFMA(fa, fk, mak); mrb = SC_MFMA(fr, fb, mrb); mrk = SC_MFMA(fr, fk, mrk); }
#pragma unroll
                for (int r = 0; r < 4; ++r) { const int t = 4 * q + r; const bool lo = n < t, le = n <= t;
                    ((LAS float*)(WB + SC_L))[t * 16 + n] = lo ? mab[r] : 0.f;
                    ((LAS bf16*)(WB + SC_AAK))[t * 16 + n] = (bf16)f2bf(lo ? mak[r] : 0.f);
                    ((LAS bf16*)(WB + SC_ARB))[t * 16 + n] = (bf16)f2bf(le ? mrb[r] : 0.f);
                    ((LAS bf16*)(WB + SC_ARK))[t * 16 + n] = (bf16)f2bf(le ? mrk[r] : 0.f); }
                { float x[16];
#pragma unroll
                    for (int t = 0; t < 16; ++t) x[t] = 0.f;
#pragma unroll
                    for (int t = 0; t < 16; ++t) { float a_ = (t == n) ? 1.f : 0.f;
#pragma unroll
                        for (int s4 = 0; s4 < (t + 3) / 4; ++s4) { const f32x4 l = *(const LAS f32x4*)(WB + SC_L + t * 64 + s4 * 16); a_ += l.x * x[4 * s4] + l.y * x[4 * s4 + 1] + l.z * x[4 * s4 + 2] + l.w * x[4 * s4 + 3]; }
                        x[t] = a_; }
                    if (q == 0) {
#pragma unroll
                        for (int t = 0; t < 16; ++t) ((LAS bf16*)(WB + SC_T))[t * 16 + n] = (bf16)f2bf(x[t]); } }
                { const bf16x8s tf = mk8(*(const LAS v2u*)(WB + SC_T + n * 32 + 8 * q), z2);
#pragma unroll
                    for (int jt = 0; jt < 4; ++jt) { const bf16x8s bfm = mk8(*(const LAS v2u*)(WB + SC_ATT + (16 * jt + n) * SC_TR + 8 * q), z2);
                        const f32x4 w = SC_MFMA(tf, bfm, ((f32x4){0.f, 0.f, 0.f, 0.f}));
#pragma unroll
                        for (int r = 0; r < 4; ++r) ((LAS bf16*)(WB + SC_W + (4 * q + r) * SC_RM))[16 * jt + n] = (bf16)f2bf(w[r]); } }
            }
            SC_BAR();
            if (!isT || phi_on) {
                int nn = n, qq = q; asm volatile("" : "+v"(nn), "+v"(qq));
                bf16x8s wf[2], rf[2];
#pragma unroll
                for (int s = 0; s < 2; ++s) { wf[s] = mk8(*(const LAS v2u*)(WB + SC_W + n * SC_RM + (32 * s + 4 * q) * 2), *(const LAS v2u*)(WB + SC_W + n * SC_RM + (32 * s + 16 + 4 * q) * 2));
                    rf[s] = mk8(*(const LAS v2u*)(WB + SC_RT + n * SC_RM + (32 * s + 4 * q) * 2), *(const LAS v2u*)(WB + SC_RT + n * SC_RM + (32 * s + 16 + 4 * q) * 2)); }
                const bf16x8s abf = mk8(*(const LAS v2u*)(WB + SC_ARB + n * 32 + 8 * q), isT ? z2 : *(const LAS v2u*)(WB + SC_ARK + n * 32 + 8 * q));
                const bf16x8s tf = mk8(*(const LAS v2u*)(WB + SC_T + n * 32 + 8 * q), z2), akf = mk8(*(const LAS v2u*)(WB + SC_AAK + n * 32 + 8 * q), z2);
                f32x4 gc[4];
#pragma unroll
                for (int jt = 0; jt < 4; ++jt) gc[jt] = *(const LAS f32x4*)(WB + SC_GC + (16 * jt + 4 * q) * 4);
#pragma unroll
                for (int it = 0; it < 4; ++it) {
                    const v2u vt = isT ? z2 : *(const LAS v2u*)(WB + SC_VT + (16 * it + n) * SC_TR + 8 * q);
                    f32x4 u = (f32x4){0.f, 0.f, 0.f, 0.f};
                    if (!isT) { const f32x4 zz = SC_MFMA(akf, mk8(vt, z2), ((f32x4){0.f, 0.f, 0.f, 0.f})); u = SC_MFMA(tf, mk8(pk4(zz), z2), u); }
                    const bf16x8s sf0 = mk8(pk4(acc[0][it]), pk4(acc[1][it])), sf1 = mk8(pk4(acc[2][it]), pk4(acc[3][it]));
                    u = SC_MFMA(wf[0], sf0, u); u = SC_MFMA(wf[1], sf1, u);
                    f32x4 y = SC_MFMA(rf[0], sf0, ((f32x4){0.f, 0.f, 0.f, 0.f})); y = SC_MFMA(rf[1], sf1, y);
                    const bf16x8s uv = mk8(pk4(u), vt);
                    y = SC_MFMA(abf, uv, y);
                    if (isT) { bf16* go = GBUF + (rows + 4 * qq) * 2048 + h * 64 + 16 * it + nn;
#pragma unroll
                        for (int r = 0; r < 4; ++r) go[(size_t)r * 2048] = (bf16)f2bf(y[r]); }
                    else { bf16* yo = YLOC + (rows + 4 * qq) * 2048 + h * 64 + 16 * it + nn;
#pragma unroll
                        for (int r = 0; r < 4; ++r) yo[(size_t)r * 2048] = (bf16)f2bf(y[r]); }
#pragma unroll
                    for (int jt = 0; jt < 4; ++jt) { const bf16x8s bk = mk8(*(const LAS v2u*)(WB + SC_BHT + (16 * jt + n) * SC_TR + 8 * q), isT ? z2 : *(const LAS v2u*)(WB + SC_KHT + (16 * jt + n) * SC_TR + 8 * q));
                        acc[jt][it] = SC_MFMA(bk, uv, acc[jt][it] * gc[jt]); }
                }
            }
            SC_BAR();
        }
        if (!isT || phi_on) { int nn = n, qq = q; asm volatile("" : "+v"(nn), "+v"(qq)); float* st = (isT ? TST : LST) + ((size_t)unit * NCH + ch) * 4096;
#pragma unroll
            for (int jt = 0; jt < 4; ++jt)
#pragma unroll
                for (int it = 0; it < 4; ++it) *(f32x4*)(st + (16 * it + nn) * 64 + 16 * jt + 4 * qq) = acc[jt][it]; }
    }
}
__device__ __forceinline__ void t_carry(Frame& F) {
    unsigned char* ws = F.ws;
    float* LST = (float*)(ws + WS_LST); const float* TST = (const float*)(ws + WS_TST);
    LAS float* SL = (LAS float*)(F.lds + RING_OFF);
    LAS float* TL = SL + 4096;
    const int tid = F.tid, i = tid >> 3, jg = tid & 7;
    for (int unit = blockIdx.x; unit < 128; unit += F.G) {
        const float* ub = LST + (size_t)unit * NCH * 4096; const float* tb = TST + (size_t)unit * NCH * 4096;
        __syncthreads();
        for (int q = tid; q < 1024; q += 512) ((LAS f32x4*)SL)[q] = ((const f32x4*)ub)[q];
        for (int q = tid; q < 1024 * (NCH - 2); q += 512) ((LAS f32x4*)TL)[q] = ((const f32x4*)(tb + 4096))[q];
        f32x4 l0[NCH - 2], l1[NCH - 2];
#pragma unroll
        for (int c = 1; c < NCH - 1; ++c) { l0[c - 1] = ((const f32x4*)(ub + (size_t)c * 4096 + i * 64 + 8 * jg))[0]; l1[c - 1] = ((const f32x4*)(ub + (size_t)c * 4096 + i * 64 + 8 * jg))[1]; }
        __syncthreads();
#pragma unroll
        for (int c = 1; c < NCH - 1; ++c) {
            f32x4 o0 = l0[c - 1], o1 = l1[c - 1]; const LAS float* tl = TL + (c - 1) * 4096;
#pragma unroll 8
            for (int j = 0; j < 64; ++j) { const float s = SL[i * 64 + j]; const f32x4 t0 = *(const LAS f32x4*)(tl + j * 64 + 8 * jg), t1 = *(const LAS f32x4*)(tl + j * 64 + 8 * jg + 4); o0 += t0 * s; o1 += t1 * s; }
            float* l_g = LST + ((size_t)unit * NCH + c) * 4096;
            ((f32x4*)(l_g + i * 64 + 8 * jg))[0] = o0; ((f32x4*)(l_g + i * 64 + 8 * jg))[1] = o1;
            WG_BAR_LDS();
            *(LAS f32x4*)(SL + i * 64 + 8 * jg) = o0; *(LAS f32x4*)(SL + i * 64 + 8 * jg + 4) = o1;
            WG_BAR_LDS();
        }
    }
}
__device__ __forceinline__ void t_fix(Frame& F) {
    typedef short bf16x8 __attribute__((ext_vector_type(8)));
    unsigned char* ws = F.ws;
    const bf16* Z = (const bf16*)(ws + WS_Z); const bf16* EAG = (const bf16*)(ws + WS_EAG); bf16* RW = (bf16*)(ws + WS_RW);
    const bf16* YLOC = (const bf16*)(ws + WS_YLOC); const bf16* GBUF = (const bf16*)(ws + WS_GBUF); const float* LST = (const float*)(ws + WS_LST); const float* RKB = (const float*)(ws + WS_RKB);
    const float* mix = F.in[8]; const float* gn_w = F.in[17]; const float* gn_b = F.in[18];
    const int lane = F.lane, n = lane & 15, q = lane >> 4;
    const int gw = F.vcu * NWAVES + F.wave, NGW = F.G * NWAVES;
    for (int it = gw; it < 128 * (SEQ / 64); it += NGW) {
        const int unit = it / (SEQ / 64), tb = it % (SEQ / 64), ch = tb / (CHL / 64), b = unit >> 5, h = unit & 31;
        const size_t row0 = (size_t)b * SEQ + (size_t)tb * 64;
        bf16x8 Af[4][2];
        if (ch > 0) { const float* sg = LST + ((size_t)unit * NCH + (ch - 1)) * 4096;
#pragma unroll
            for (int mt = 0; mt < 4; ++mt)
#pragma unroll
                for (int ks = 0; ks < 2; ++ks) { const f32x4 s0 = *(const f32x4*)(sg + (16 * mt + n) * 64 + 32 * ks + 8 * q), s1 = *(const f32x4*)(sg + (16 * mt + n) * 64 + 32 * ks + 8 * q + 4);
                    u32x4_t w; w.x = pk2(s0.x, s0.y); w.y = pk2(s0.z, s0.w); w.z = pk2(s1.x, s1.y); w.w = pk2(s1.z, s1.w); Af[mt][ks] = __builtin_bit_cast(bf16x8, w); } }
        f32x4 gwv[4], gbv[4], mvv[4];
#pragma unroll
        for (int mt = 0; mt < 4; ++mt) { const int c = h * 64 + 16 * mt + 4 * q; gwv[mt] = *(const f32x4*)(gn_w + c); gbv[mt] = *(const f32x4*)(gn_b + c); mvv[mt] = *(const f32x4*)(mix + 4096 + c); }
#pragma unroll 1
        for (int nt = 0; nt < 4; ++nt) {
            const int t = 16 * nt + n, tt = tb * 64 + t; const size_t row = row0 + t;
            f32x4 y[4];
#pragma unroll
            for (int mt = 0; mt < 4; ++mt) { const v2u yw = *(const v2u*)(YLOC + row * 2048 + h * 64 + 16 * mt + 4 * q); y[mt] = (f32x4){blo(yw.x), bhi(yw.x), blo(yw.y), bhi(yw.y)}; }
            v2u vc[4], vp[4], gt[4];
#pragma unroll
            for (int mt = 0; mt < 4; ++mt) { const bf16* zr = Z + row * NZP + 4096 + h * 64 + 16 * mt + 4 * q; vc[mt] = *(const v2u*)zr; vp[mt] = tt > 0 ? *(const v2u*)(zr - NZP) : (v2u){0u, 0u};
                gt[mt] = *(const v2u*)(EAG + (size_t)2 * M * 2048 + row * 2048 + h * 64 + 16 * mt + 4 * q); }
            const float rk = RKB[row * 32 + h];
            if (ch > 0) { bf16x8 Bf[2];
#pragma unroll
                for (int ks = 0; ks < 2; ++ks) Bf[ks] = *(const bf16x8*)(GBUF + row * 2048 + h * 64 + 32 * ks + 8 * q);
#pragma unroll
                for (int mt = 0; mt < 4; ++mt) { f32x4 acc = (f32x4){0.f, 0.f, 0.f, 0.f};
#pragma unroll
                    for (int ks = 0; ks < 2; ++ks) acc = __builtin_amdgcn_mfma_f32_16x16x32_bf16(Af[mt][ks], Bf[ks], acc, 0, 0, 0);
                    y[mt] += acc; } }
            float s = 0.f;
#pragma unroll
            for (int mt = 0; mt < 4; ++mt) s += (y[mt].x + y[mt].y) + (y[mt].z + y[mt].w);
            s += __shfl_xor(s, 16); s += __shfl_xor(s, 32);
            const float mu = s * (1.0f / 64.0f); float vs = 0.f;
#pragma unroll
            for (int mt = 0; mt < 4; ++mt) { y[mt] = y[mt] - mu; vs += (y[mt].x * y[mt].x + y[mt].y * y[mt].y) + (y[mt].z * y[mt].z + y[mt].w * y[mt].w); }
            vs += __shfl_xor(vs, 16); vs += __shfl_xor(vs, 32);
            const float rstd = __builtin_amdgcn_rsqf(vs * (1.0f / 64.0f) + 64e-5f);
#pragma unroll
            for (int mt = 0; mt < 4; ++mt) {
                const f32x4 vcur = (f32x4){blo(vc[mt].x), bhi(vc[mt].x), blo(vc[mt].y), bhi(vc[mt].y)}, vprv = (f32x4){blo(vp[mt].x), bhi(vp[mt].x), blo(vp[mt].y), bhi(vp[mt].y)};
                const f32x4 v = vcur + mvv[mt] * (vprv - vcur), g = (f32x4){blo(gt[mt].x), bhi(gt[mt].x), blo(gt[mt].y), bhi(gt[mt].y)};
                const f32x4 o = (y[mt] * rstd * gwv[mt] + gbv[mt] + v * rk) * g;
                v2u w; w.x = pk2(o.x, o.y); w.y = pk2(o.z, o.w); *(v2u*)(RW + row * 2048 + h * 64 + 16 * mt + 4 * q) = w; }
        }
    }
}

struct Args { const float* in[27]; float* out; unsigned char* ws; int ph_lo, ph_hi; };
__global__ void __launch_bounds__(NWAVES * 64, 2) mk_fwd(Args args) {
    extern __shared__ __attribute__((aligned(16))) unsigned char lds[];
    Frame F;
    F.lds = (LAS unsigned char*)lds;
    F.MISC = (volatile LAS unsigned*)(F.lds + MISC_OFF);
    F.tid = threadIdx.x; F.lane = F.tid & 63; F.wave = __builtin_amdgcn_readfirstlane(F.tid >> 6);
    F.G = gridDim.x; { const int bx = blockIdx.x; F.vcu = (F.G % 8 == 0) ? (bx % 8) * (F.G / 8) + bx / 8 : bx; }
#pragma unroll
    for (int i = 0; i < 27; ++i) F.in[i] = args.in[i];
    F.out = args.out; F.ws = args.ws; unsigned char* ws = args.ws;
    F.ctl = (gu32*)(ws + WS_CTL);
    for (int u = F.tid; u < (LDS_BYTES - LDSCTL_OFF) / 4; u += NWAVES * 64) ((LAS unsigned*)(F.lds + LDSCTL_OFF))[u] = 0u;
    __syncthreads();
    const int lo = args.ph_lo, hi = args.ph_hi;
#if MK_ONE_LAUNCH
    XcdBarrier bar = xcd_barrier_post((unsigned*)(F.ctl + CW_BAR), F.MISC + 8);
#define GRID_BAR() xcd_barrier(bar)
#else
#define GRID_BAR() do {} while (0)
#endif
#define IN(k) (lo <= (k) && (k) < hi)
#define BOTH(k) (IN(k) && IN((k) + 1))
    bf16* XB = (bf16*)(ws + WS_XB); float* RSTD = (float*)(ws + WS_RSTD);
    const int bx = (int)blockIdx.x;

    if (IN(P_PRO)) { p_prologue(F); if (BOTH(P_PRO)) GRID_BAR(); }
    if (IN(G_WIN)) {
        {
            pg8::Gemm g{(const bf16*)(ws + WS_X8), (const bf16*)(ws + WS_WIN8), M, NQKV, D / 2, D / 2, D / 2, 0}; pg8::StaticOrder S; S.init(M, NQKV, F.G, bx);
            pg8::EpiWin8 E{(bf16*)(ws + WS_QKV), (bf16*)(ws + WS_Z), (bf16*)(ws + WS_GT), RSTD, (const float*)(ws + WS_SX), (const float*)(ws + WS_SW), 0};
            pg8::gemm_phase<pg8::EpiWin8, pg8::StaticOrder, true, true, true>(F.lds + RING_OFF, g, S, E);
        }
        {
            pg8::Gemm g{XB, (const bf16*)(ws + WS_WZT), M, NZP, D, D, D, 0}; pg8::StaticOrder S; S.init(M, NZP, F.G, (bx + F.G / 2) % F.G);
            pg8::EpiWin E{(bf16*)(ws + WS_QKV), (bf16*)(ws + WS_Z), (bf16*)(ws + WS_GT), RSTD, 18};
            pg8::gemm_phase<pg8::EpiWin, pg8::StaticOrder, true, true>(F.lds + RING_OFF, g, S, E);
        }
        {
            pg8::Gemm g{(const bf16*)(ws + WS_X8), (const bf16*)(ws + WS_WIN8 + (size_t)11264 * D), M, NGT, D / 2, D / 2, D / 2, 0}; pg8::StaticOrder S; S.init(M, NGT, F.G, bx);
            pg8::EpiWin8 E{(bf16*)(ws + WS_QKV), (bf16*)(ws + WS_Z), (bf16*)(ws + WS_GT), RSTD, (const float*)(ws + WS_SX), (const float*)(ws + WS_SW), 44};
            pg8::gemm_phase<pg8::EpiWin8, pg8::StaticOrder, true, true, true>(F.lds + RING_OFF, g, S, E);
        }
        if (BOTH(G_WIN)) GRID_BAR();
    }
    if (IN(T_ATTN)) { t_attn(F); __syncthreads(); t_lora_in(F); if (BOTH(T_ATTN)) GRID_BAR(); }
    if (IN(G_LORA)) {
        pg8::Gemm g{(const bf16*)(ws + WS_ALORA), (const bf16*)(ws + WS_WLORA), M, LORAN, LORAK, LORAK, LORAK, 1}; pg8::StaticOrder S; S.init(M, LORAN, F.G, bx);
        pg8::EpiLora E{(bf16*)(ws + WS_EAG), F.in[9], F.in[11], (size_t)M * 2048};
        pg8::gemm_phase<pg8::EpiLora, pg8::StaticOrder, true, true>(F.lds + RING_OFF, g, S, E);
        if (BOTH(G_LORA)) GRID_BAR();
    }
    if (IN(T_SCAN)) { t_scan1(F); if (BOTH(T_SCAN)) GRID_BAR(); }
    if (IN(T_CARRY)) {
        if (F.G >= 256) { if (bx >= 128) late_conversions(F, bx - 128, F.G - 128); } else late_conversions(F, bx, F.G);
        t_carry(F); __syncthreads(); attn_merge(F); if (BOTH(T_CARRY)) GRID_BAR(); }
    if (IN(T_FIX)) { t_fix(F); if (BOTH(T_FIX)) GRID_BAR(); }
    if (IN(G_ATTUP)) {
        pg8::Gemm g{(const bf16*)(ws + WS_ATT), (const bf16*)(ws + WS_WATT), M, D, AOW, AOW, AOW, 0}; pg8::StaticOrder S; S.init(M, D, F.G, bx);
        pg8::EpiB<2> E{(bf16*)(ws + WS_AD), D, nullptr, (const bf16*)(ws + WS_GT), nullptr, nullptr};
        pg8::gemm_phase<pg8::EpiB<2>, pg8::StaticOrder, true, true>(F.lds + RING_OFF, g, S, E);
    }
    if (IN(G_RWUP)) {
        pg8::Gemm g{(const bf16*)(ws + WS_RW), (const bf16*)(ws + WS_WRW), M, D, RWW, RWW, RWW, 0}; pg8::StaticOrder S; S.init(M, D, F.G, bx);
        pg8::EpiB<3> E{(bf16*)(ws + WS_MERGED), D, nullptr, (const bf16*)(ws + WS_GT), (const bf16*)(ws + WS_AD), (unsigned*)(ws + CTL_RMAX3)};
        pg8::gemm_phase<pg8::EpiB<3>, pg8::StaticOrder, true, true>(F.lds + RING_OFF, g, S, E);
        if (BOTH(G_RWUP)) GRID_BAR();
    }
    if (IN(G_OUT)) {
        rows_bf16_to_i8(F, (const bf16*)(ws + WS_MERGED), (const unsigned*)(ws + CTL_RMAX3), (unsigned*)(ws + WS_X8C), (float*)(ws + WS_SX3));
        GRID_BAR();
        pg8::Gemm g{(const bf16*)(ws + WS_X8C), (const bf16*)(ws + WS_W8O), M, D, D / 2, D / 2, D / 2, 0}; pg8::StaticOrder S; S.init(M, D, F.G, bx);
        pg8::EpiF<0, true> E{F.in[0], F.out, nullptr, nullptr, XB, (float*)(ws + CTL_SS2), (unsigned*)(ws + CTL_RMAX2), (const float*)(ws + WS_SX3), (const float*)(ws + WS_SWO)};
        pg8::gemm_phase<pg8::EpiF<0, true>, pg8::StaticOrder, true, true, true>(F.lds + RING_OFF, g, S, E);
        { int t2 = threadIdx.x; asm volatile("" : "+v"(t2)); F.tid = t2; F.lane = t2 & 63; F.wave = __builtin_amdgcn_readfirstlane(t2 >> 6); }
        transpose_matrix(F, F.in[23], DFF, D, (bf16*)(ws + WS_WMLPOUT), nullptr, 1 << 30, 0);
        quantize_matrix(F, F.in[25], D, D, (signed char*)(ws + WS_W8P), F.in[24], (const unsigned*)(ws + CTL_CMAXP), (float*)(ws + WS_SWP), 1 << 30, 0, 1 << 30);
        transpose_matrix(F, F.in[26], PLE, D, (bf16*)(ws + WS_WPLEP), nullptr, 1 << 30, 0);
        if (BOTH(G_OUT)) GRID_BAR();
    }
    if (IN(T_N2)) {
        rows_bf16_to_i8(F, XB, (const unsigned*)(ws + CTL_RMAX2), (unsigned*)(ws + WS_X8B), (float*)(ws + WS_SX2));
        if (BOTH(T_N2)) GRID_BAR();
    }
    if (IN(G_MLPIN)) {
        pg8::Gemm g{(const bf16*)(ws + WS_X8B), (const bf16*)(ws + WS_W8M), M, DFF, D / 2, D / 2, D / 2, 0}; pg8::StaticOrder S; S.init(M, DFF, F.G, bx);
        pg8::EpiMlp8 E{(bf16*)(ws + WS_HID), DFF, (const float*)(ws + CTL_SS2), (const float*)(ws + WS_SX2), (const float*)(ws + WS_SWM)};
        pg8::gemm_phase<pg8::EpiMlp8, pg8::StaticOrder, true, true, true>(F.lds + RING_OFF, g, S, E);
        if (BOTH(G_MLPIN)) GRID_BAR();
    }
    if (IN(G_MLPOUT)) {
        { pg8::Gemm g{(const bf16*)(ws + WS_HID), (const bf16*)(ws + WS_WMLPOUT), M, D, DFF, DFF, DFF, 0}; pg8::StaticOrder S; S.init(M, D, F.G, bx);
          pg8::EpiF<0> E{F.out, F.out, nullptr, nullptr, XB, (float*)(ws + CTL_SS3), (unsigned*)(ws + CTL_RMAX4), nullptr, nullptr};
          pg8::gemm_phase<pg8::EpiF<0>, pg8::StaticOrder, true, true>(F.lds + RING_OFF, g, S, E); }
        if (BOTH(G_MLPOUT)) GRID_BAR();
    }
    if (IN(G_PP)) {
        rows_bf16_to_i8(F, XB, (const unsigned*)(ws + CTL_RMAX4), (unsigned*)(ws + WS_X8D), (float*)(ws + WS_SX4));
        {
            pg8::Gemm g2{(const bf16*)(ws + WS_PB), (const bf16*)(ws + WS_WPLEP), M, D, PLE, PLE, PLE, 0}; pg8::StaticOrder S2; S2.init(M, D, F.G, bx);
            pg8::EpiB<0> E2{(bf16*)(ws + WS_PP), D, nullptr, nullptr, nullptr, nullptr};
            pg8::gemm_phase<pg8::EpiB<0>, pg8::StaticOrder, true, true>(F.lds + RING_OFF, g2, S2, E2);
        }
        if (BOTH(G_PP)) GRID_BAR();
    }
    if (IN(G_PLE)) {
        pg8::Gemm g{(const bf16*)(ws + WS_X8D), (const bf16*)(ws + WS_W8P), M, D, D / 2, D / 2, D / 2, 0}; pg8::StaticOrder S; S.init(M, D, F.G, bx);
        pg8::EpiF<1, true> E{F.out, F.out, (const float*)(ws + CTL_SS3), (const bf16*)(ws + WS_PP), nullptr, nullptr, nullptr, (const float*)(ws + WS_SX4), (const float*)(ws + WS_SWP)};
        pg8::gemm_phase<pg8::EpiF<1, true>, pg8::StaticOrder, true, true, true>(F.lds + RING_OFF, g, S, E);
    }
#undef IN
#undef BOTH
}

extern "C" void kernel_launch(void* const* d_in, const int* in_sizes, int n_in, void* d_out, int out_size, void* d_ws, size_t ws_size, hipStream_t stream) {
    static int grid = 0;
    if (grid == 0) {
        if (n_in != 27 || in_sizes[0] != M * D || out_size != M * D || ws_size < WS_END) { fprintf(stderr, "kernel_launch: unexpected shapes: n_in %d in0 %d out %d ws %zu (need %zu)\n", n_in, n_in > 0 ? in_sizes[0] : -1, out_size, ws_size, (size_t)WS_END); grid = -1; return; }
        int dev = 0, cus = 0, per_cu = 0;
        if (hipGetDevice(&dev) != hipSuccess || hipDeviceGetAttribute(&cus, hipDeviceAttributeMultiprocessorCount, dev) != hipSuccess) { grid = -1; return; }
        if (hipFuncSetAttribute((const void*)mk_fwd, hipFuncAttributeMaxDynamicSharedMemorySize, LDS_BYTES) != hipSuccess) { fprintf(stderr, "kernel_launch: hipFuncSetAttribute failed\n"); grid = -1; return; }
        if (hipOccupancyMaxActiveBlocksPerMultiprocessor(&per_cu, (const void*)mk_fwd, NWAVES * 64, LDS_BYTES) != hipSuccess || per_cu < 1)
            fprintf(stderr, "kernel_launch: note: occupancy query reports %d workgroups per CU\n", per_cu);
        (void)hipGetLastError();
        grid = cus;
    }
    if (grid < 0) return;
    if (hipMemsetAsync((char*)d_ws + WS_CTL, 0, CTL_ZERO_BYTES, stream) != hipSuccess) return;
    Args a{};
    for (int i = 0; i < 27; ++i) a.in[i] = (const float*)d_in[i];
    a.out = (float*)d_out; a.ws = (unsigned char*)d_ws;
#if MK_ONE_LAUNCH
    a.ph_lo = 0; a.ph_hi = NPH;
    hipLaunchKernelGGL(mk_fwd, dim3(grid), dim3(NWAVES * 64), LDS_BYTES, stream, a);
#else
    for (int ph = 0; ph < NPH; ++ph) { a.ph_lo = ph; a.ph_hi = ph + 1; hipLaunchKernelGGL(mk_fwd, dim3(grid), dim3(NWAVES * 64), LDS_BYTES, stream, a); }
#endif
}
```

```cpp
#include <hip/hip_runtime.h>
#include <cstdio>
#include <cstdint>
namespace pg8 {
#define PG8_LAS __attribute__((address_space(3)))
typedef unsigned short bf16_t;
typedef short bf16x8 __attribute__((ext_vector_type(8)));
typedef float f32x4 __attribute__((ext_vector_type(4)));
typedef unsigned u32x4 __attribute__((ext_vector_type(4)));
typedef unsigned u32x2 __attribute__((ext_vector_type(2)));
constexpr int BM = 256, BK = 64, HALF = 128, HTB = HALF * BK * 2  , STAGE_BYTES = 8 * HTB, NXCD = 8, WGM = 8;

__host__ __device__ __forceinline__ int lds_byte(int r, int c) { const int st = (r >> 4) * 2 + (c >> 5), rr = r & 15, cc = c & 31, ob = rr * 64 + cc * 2; return st * 1024 + (ob ^ (((ob >> 9) & 1) << 5)); }
__host__ __device__ __forceinline__ void stage_rc(int b, int& R, int& C) { const int st = b / 1024, sb = b % 1024, swz = sb ^ (((sb >> 9) & 1) << 5); R = (st >> 1) * 16 + swz / 64; C = (st & 1) * 32 + (swz % 64) / 2; }
__host__ __device__ __forceinline__ int perm32(int rho) { const int n = rho >> 4, i = rho & 15; return 8 * (i >> 2) + 4 * n + (i & 3); }

struct Unit { int pm, pn; };
struct Gemm { const bf16_t* A; const bf16_t* Bt; int M, N, K, lda, ldb, kmode; };

struct StaticOrder {
    int nM, nN, nwg, G, c;
    __host__ __device__ void init(int M, int N, int G_, int c_) { nM = M / BM; nN = N / BM; nwg = nM * nN; G = G_; c = c_; }
    __host__ __device__ bool next(int i, Unit& u) const {
        const long L = (long)i * G + c; if (L >= nwg) return false;
        int wgid = (int)L; { const int q = nwg / NXCD, r = nwg % NXCD, xcd = wgid % NXCD, off = wgid / NXCD; wgid = (xcd < r ? xcd * (q + 1) : r * (q + 1) + (xcd - r) * q) + off; }
        const int nig = WGM * nN, gid = wgid / nig, fm = gid * WGM, gsz = (nM - fm) < WGM ? (nM - fm) : WGM;
        u.pm = fm + ((wgid % nig) % gsz); u.pn = (wgid % nig) / gsz; return true;
    }
    __device__ __forceinline__ void a_ready(const Unit&) const {}
    __device__ __forceinline__ void done(const Unit&) const {}
};
typedef float cvt_f2 __attribute__((ext_vector_type(2)));
typedef __bf16 cvt_b2 __attribute__((ext_vector_type(2)));
__device__ __forceinline__ unsigned cvt_pk_bf16_n(float lo, float hi) { const cvt_f2 x = {lo, hi}; return __builtin_bit_cast(unsigned, __builtin_convertvector(x, cvt_b2)); }
__device__ __forceinline__ unsigned cvt_pk_bf16(float lo, float hi) { unsigned r; asm volatile("s_nop 0\n\tv_cvt_pk_bf16_f32 %0, %1, %2" : "=v"(r) : "v"(lo), "v"(hi)); return r; }
typedef int i32x4 __attribute__((ext_vector_type(4)));
template <bool I8> struct AccT { typedef f32x4 type; };
template <> struct AccT<true> { typedef i32x4 type; };
template <bool I8> __device__ __forceinline__ typename AccT<I8>::type mma_(const bf16x8 a, const bf16x8 b, const typename AccT<I8>::type c) {
    if constexpr (I8) return __builtin_amdgcn_mfma_i32_16x16x64_i8(__builtin_bit_cast(i32x4, a), __builtin_bit_cast(i32x4, b), c, 0, 0, 0);
    else return __builtin_amdgcn_mfma_f32_16x16x32_bf16(a, b, c, 0, 0, 0);
}
__device__ __forceinline__ float bf_lo(unsigned w) { return __builtin_bit_cast(float, w << 16); }
__device__ __forceinline__ float bf_hi(unsigned w) { return __builtin_bit_cast(float, w & 0xffff0000u); }
__device__ __forceinline__ float sigmoidf_(float x) { return __builtin_amdgcn_rcpf(1.0f + __builtin_amdgcn_exp2f(-1.4426950408889634f * x)); }

template <class Epi, class Sched, bool ALIGN_EPI = false, bool SP2 = false, bool I8 = false>
__device__ __forceinline__ void gemm_phase(PG8_LAS unsigned char* lds, const Gemm g, const Sched& S, const Epi& E) {
    const int tid = threadIdx.x, wid = __builtin_amdgcn_readfirstlane(tid >> 6), lane = tid & 63, wr = wid >> 2, wc = wid & 3, fr = lane & 15, fq = lane >> 4;
    const int K = g.K;
#define PG8_K0B(u) (g.kmode ? (((u).pn >> 3) == 0 ? 0 : (((u).pn >> 3) == 1 ? 128 : 384)) : 0)
#define PG8_NT(u) (g.kmode ? (((u).pn >> 3) == 2 ? 4 : 2) : K / BK)
    unsigned voffA[2], voffB[2];
#pragma unroll
    for (int i = 0; i < 2; ++i) { int R, C; stage_rc(tid * 16 + i * 8192, R, C); const int Rb = Epi::PERM ? ((R & ~31) + perm32(R & 31)) : R;
        voffA[i] = (unsigned)(R * g.lda + C) * 2u; voffB[i] = (unsigned)(Rb * g.ldb + C) * 2u; }
    const size_t kstep = (size_t)(BK * 2);
    const size_t hstepA = (size_t)HALF * g.lda * 2, hstepB = (size_t)HALF * g.ldb * 2;
    const size_t tstepA = 2 * hstepA, tstepB = 2 * hstepB;
    const unsigned ldsw = (unsigned)wid * 1024u;
    const int aoff = lds_byte(wr * 64 + fr, fq * 8), boff = lds_byte(wc * 32 + fr, fq * 8);
#define PG8_SA(b, h) (((b) * 2 + (h)) * HTB)
#define PG8_SB(b, h) ((4 + (b) * 2 + (h)) * HTB)
#define PG8_STAGE(bufoff, gbase, voff) do { _Pragma("unroll") for (int _i = 0; _i < 2; ++_i) \
        __builtin_amdgcn_global_load_lds((const unsigned*)((const char*)(gbase) + (voff)[_i]), (PG8_LAS unsigned*)(lds + (bufoff) + ldsw + _i * 8192), 16, 0, 0); } while (0)
#define PG8_LDA(dst, b, h) do { _Pragma("unroll") for (int m = 0; m < 4; ++m) _Pragma("unroll") for (int k = 0; k < 2; ++k) dst[m][k] = *(const PG8_LAS bf16x8*)(lds + PG8_SA(b, h) + aoff + m * 2048 + k * 1024); } while (0)
#define PG8_LDB(dst, b, h) do { _Pragma("unroll") for (int n = 0; n < 2; ++n) _Pragma("unroll") for (int k = 0; k < 2; ++k) dst[n][k] = *(const PG8_LAS bf16x8*)(lds + PG8_SB(b, h) + boff + n * 2048 + k * 1024); } while (0)
#define PG8_MMA(ai, bj, At, Bt) do { __builtin_amdgcn_s_setprio(1); _Pragma("unroll") for (int m = 0; m < 4; ++m) _Pragma("unroll") for (int n = 0; n < 2; ++n) _Pragma("unroll") for (int k = 0; k < 2; ++k) \
        acc[ai][bj][m][n] = mma_<I8>(Bt[n][k], At[m][k], acc[ai][bj][m][n]); __builtin_amdgcn_s_setprio(0); } while (0)
#define PG8_WAIT_V(n) asm volatile("s_waitcnt vmcnt(" #n ")" ::: "memory")
#define PG8_WAIT_L(n) asm volatile("s_waitcnt lgkmcnt(" #n ")" ::: "memory")
#define PG8_BAR __builtin_amdgcn_s_barrier()
#define PG8_SCHED __builtin_amdgcn_sched_barrier(0)
    Unit cur, nxt; int ui = 0;
    if (!S.next(0, cur)) return;
    typename AccT<I8>::type acc[2][2][4][2];
#pragma unroll
    for (int a = 0; a < 2; ++a)
#pragma unroll
        for (int b = 0; b < 2; ++b)
#pragma unroll
            for (int m = 0; m < 4; ++m)
#pragma unroll
                for (int n = 0; n < 2; ++n) acc[a][b][m][n] = (typename AccT<I8>::type){0, 0, 0, 0};
    bf16x8 At[4][2], B0[2][2], B1[2][2];
    const char* cA = (const char*)g.A + (size_t)cur.pm * tstepA + PG8_K0B(cur); const char* cB = (const char*)g.Bt + (size_t)cur.pn * tstepB + PG8_K0B(cur);
    int nt = PG8_NT(cur);
    S.a_ready(cur);
    if constexpr (SP2) {
        PG8_STAGE(PG8_SB(0, 0), cB, voffB); PG8_STAGE(PG8_SB(0, 1), cB + hstepB, voffB); PG8_STAGE(PG8_SA(0, 0), cA, voffA); PG8_STAGE(PG8_SA(0, 1), cA + hstepA, voffA);
        if (wr == 1) PG8_BAR;
        PG8_WAIT_V(2); PG8_BAR;
        PG8_STAGE(PG8_SB(1, 0), cB + kstep, voffB); PG8_STAGE(PG8_SA(1, 0), cA + kstep, voffA); PG8_STAGE(PG8_SB(1, 1), cB + hstepB + kstep, voffB);
        PG8_WAIT_V(6); PG8_BAR;
    } else {
        PG8_STAGE(PG8_SB(0, 0), cB, voffB); PG8_STAGE(PG8_SA(0, 0), cA, voffA); PG8_STAGE(PG8_SB(0, 1), cB + hstepB, voffB); PG8_STAGE(PG8_SA(0, 1), cA + hstepA, voffA);
        if (wr == 1) PG8_BAR;
        PG8_WAIT_V(4); PG8_BAR;
        PG8_STAGE(PG8_SB(1, 0), cB + kstep, voffB); PG8_STAGE(PG8_SA(1, 0), cA + kstep, voffA); PG8_STAGE(PG8_SB(1, 1), cB + hstepB + kstep, voffB);
        PG8_WAIT_V(6); PG8_BAR;
    }
    for (;;) {
        const bool has_next = S.next(ui + 1, nxt);
        const char* nA = has_next ? (const char*)g.A + (size_t)nxt.pm * tstepA + PG8_K0B(nxt) : cA; const char* nB = has_next ? (const char*)g.Bt + (size_t)nxt.pn * tstepB + PG8_K0B(nxt) : cB;
        for (int t = 0; t < nt; t += 2) {
            const bool last = (t == nt - 2);
            const char* a1 = cA + (size_t)(t + 1) * kstep;
            const char* a2 = last ? nA : cA + (size_t)(t + 2) * kstep; const char* b2 = last ? nB : cB + (size_t)(t + 2) * kstep;
            const char* a3 = a2 + kstep; const char* b3 = b2 + kstep;
            if (last && has_next) S.a_ready(nxt);
            if constexpr (SP2) {
            PG8_LDB(B0, 0, 0); PG8_LDB(B1, 0, 1); PG8_SCHED; PG8_LDA(At, 0, 0); PG8_STAGE(PG8_SA(1, 1), a1 + hstepA, voffA);
            PG8_WAIT_V(8); PG8_WAIT_L(0); PG8_BAR; PG8_MMA(0, 0, At, B0); PG8_MMA(0, 1, At, B1); PG8_BAR; PG8_SCHED;
            PG8_LDA(At, 0, 1); PG8_STAGE(PG8_SB(0, 0), b2, voffB); PG8_STAGE(PG8_SB(0, 1), b2 + hstepB, voffB); PG8_STAGE(PG8_SA(0, 0), a2, voffA);
            PG8_WAIT_V(8); PG8_WAIT_L(0); PG8_BAR; PG8_MMA(1, 0, At, B0); PG8_MMA(1, 1, At, B1); PG8_BAR; PG8_SCHED;
            PG8_LDB(B0, 1, 0); PG8_LDB(B1, 1, 1); PG8_SCHED; PG8_LDA(At, 1, 0); PG8_STAGE(PG8_SA(0, 1), a2 + hstepA, voffA);
            PG8_WAIT_V(8); PG8_WAIT_L(0); PG8_BAR; PG8_MMA(0, 0, At, B0); PG8_MMA(0, 1, At, B1); PG8_BAR; PG8_SCHED;
            PG8_LDA(At, 1, 1); PG8_STAGE(PG8_SB(1, 0), b3, voffB); PG8_STAGE(PG8_SB(1, 1), b3 + hstepB, voffB); PG8_STAGE(PG8_SA(1, 0), a3, voffA);
            PG8_WAIT_V(8); PG8_WAIT_L(0); PG8_BAR; PG8_MMA(1, 0, At, B0); PG8_MMA(1, 1, At, B1); PG8_BAR; PG8_SCHED;
            } else {
            PG8_LDB(B0, 0, 0); PG8_SCHED; PG8_LDA(At, 0, 0); PG8_STAGE(PG8_SA(1, 1), a1 + hstepA, voffA);
            PG8_WAIT_L(8); PG8_BAR; PG8_WAIT_L(0); PG8_MMA(0, 0, At, B0); PG8_BAR; PG8_SCHED;
            PG8_LDB(B1, 0, 1); PG8_STAGE(PG8_SB(0, 0), b2, voffB);
            PG8_BAR; PG8_WAIT_L(0); PG8_MMA(0, 1, At, B1); PG8_BAR;
            PG8_LDA(At, 0, 1); PG8_STAGE(PG8_SA(0, 0), a2, voffA);
            PG8_BAR; PG8_WAIT_L(0); PG8_MMA(1, 0, At, B0); PG8_BAR; PG8_SCHED;
            PG8_STAGE(PG8_SB(0, 1), b2 + hstepB, voffB);
            PG8_WAIT_V(6); PG8_BAR; PG8_MMA(1, 1, At, B1); PG8_BAR;
            PG8_LDB(B0, 1, 0); PG8_SCHED; PG8_LDA(At, 1, 0); PG8_STAGE(PG8_SA(0, 1), a2 + hstepA, voffA);
            PG8_WAIT_L(8); PG8_BAR; PG8_WAIT_L(0); PG8_MMA(0, 0, At, B0); PG8_BAR; PG8_SCHED;
            PG8_LDB(B1, 1, 1); PG8_STAGE(PG8_SB(1, 0), b3, voffB);
            PG8_BAR; PG8_WAIT_L(0); PG8_MMA(0, 1, At, B1); PG8_BAR;
            PG8_LDA(At, 1, 1); PG8_STAGE(PG8_SA(1, 0), a3, voffA);
            PG8_BAR; PG8_WAIT_L(0); PG8_MMA(1, 0, At, B0); PG8_BAR; PG8_SCHED;
            PG8_STAGE(PG8_SB(1, 1), b3 + hstepB, voffB);
            PG8_WAIT_V(6); PG8_BAR; PG8_MMA(1, 1, At, B1); PG8_BAR;
            }
        }
        if constexpr (ALIGN_EPI) { if (wr == 0) PG8_BAR; }
        if constexpr (!Epi::AFTER_DRAIN) { int t2 = threadIdx.x; asm volatile("" : "+v"(t2)); const int w2 = t2 >> 6, l2 = t2 & 63; E(acc, cur, w2 >> 2, w2 & 3, l2 & 15, l2 >> 4); S.done(cur); }
        if (!has_next) break;
#pragma unroll
        for (int a = 0; a < 2; ++a)
#pragma unroll
            for (int b = 0; b < 2; ++b)
#pragma unroll
                for (int m = 0; m < 4; ++m)
#pragma unroll
                    for (int n = 0; n < 2; ++n) acc[a][b][m][n] = (typename AccT<I8>::type){0, 0, 0, 0};
        cur = nxt; cA = nA; cB = nB; ++ui; nt = PG8_NT(cur);
        if constexpr (ALIGN_EPI) { if (wr == 1) PG8_BAR; }
    }
    PG8_WAIT_V(0);
    if constexpr (!ALIGN_EPI) { if (wr == 0) PG8_BAR; }
    PG8_BAR;
    if constexpr (Epi::AFTER_DRAIN) { E.fused(acc, cur, wr, wc, fr, fq, lds, wid, lane); S.done(cur); }
#undef PG8_SA
#undef PG8_SB
#undef PG8_STAGE
#undef PG8_LDA
#undef PG8_LDB
#undef PG8_MMA
#undef PG8_WAIT_V
#undef PG8_WAIT_L
#undef PG8_BAR
#undef PG8_SCHED
#undef PG8_K0B
#undef PG8_NT
}

typedef const f32x4 (&AccRef)[2][2][4][2];
__device__ __forceinline__ u32x4 pack8(const f32x4 v0, const f32x4 v1) { u32x4 w; w.x = cvt_pk_bf16(v0[0], v0[1]); w.y = cvt_pk_bf16(v0[2], v0[3]); w.z = cvt_pk_bf16(v1[0], v1[1]); w.w = cvt_pk_bf16(v1[2], v1[3]); return w; }
__device__ __forceinline__ void unpack8(const u32x4 w, f32x4& v0, f32x4& v1) { v0 = (f32x4){bf_lo(w.x), bf_hi(w.x), bf_lo(w.y), bf_hi(w.y)}; v1 = (f32x4){bf_lo(w.z), bf_hi(w.z), bf_lo(w.w), bf_hi(w.w)}; }
__device__ __forceinline__ f32x4 sig4(const f32x4 v) { return (f32x4){sigmoidf_(v[0]), sigmoidf_(v[1]), sigmoidf_(v[2]), sigmoidf_(v[3])}; }

struct EpiWin {
    static constexpr bool PERM = true, AFTER_DRAIN = false;
    bf16_t* QKV; bf16_t* Z; bf16_t* GT; const float* rstd; int pn0;
    __device__ __forceinline__ void operator()(AccRef acc, const Unit& uu, int wr, int wc, int fr, int fq) const {
        Unit u = uu; u.pn += pn0;
        const int row0 = u.pm * BM + wr * 64 + fr;
        bf16_t* base; int ldc, colt; bool sg = false;
        if (u.pn < 18) { base = QKV; ldc = 4608; colt = u.pn * 256; }
        else if (u.pn < 44) { base = Z; ldc = 6656; colt = (u.pn - 18) * 256; }
        else { base = GT; ldc = 8192; colt = (u.pn - 44) * 256; sg = true; }
        const int col0 = colt + wc * 32 + 8 * fq;
        float rsv[2][4];
#pragma unroll
        for (int ai = 0; ai < 2; ++ai)
#pragma unroll
            for (int m = 0; m < 4; ++m) rsv[ai][m] = rstd[row0 + ai * HALF + m * 16];
#pragma unroll
        for (int ai = 0; ai < 2; ++ai)
#pragma unroll
            for (int m = 0; m < 4; ++m) { const int r = row0 + ai * HALF + m * 16; const float rs = rsv[ai][m]; bf16_t* rowp = base + (size_t)r * ldc + col0;
#pragma unroll
                for (int bj = 0; bj < 2; ++bj) { f32x4 v0 = acc[ai][bj][m][0] * rs, v1 = acc[ai][bj][m][1] * rs;
                    if (sg) { v0 = sig4(v0); v1 = sig4(v1); }
                    *(u32x4*)(rowp + bj * HALF) = pack8(v0, v1); } }
    }
};
struct EpiWin8 {
    static constexpr bool PERM = true, AFTER_DRAIN = false;
    bf16_t* QKV; bf16_t* Z; bf16_t* GT; const float* rstd; const float* sx; const float* sw; int pn0;
    __device__ __forceinline__ void operator()(const i32x4 (&acc)[2][2][4][2], const Unit& uu, int wr, int wc, int fr, int fq) const {
        Unit u = uu; u.pn += pn0;
        const int row0 = u.pm * BM + wr * 64 + fr, cl = wc * 32 + 8 * fq;
        bf16_t* base; int ldc, colt; bool sg = false;
        if (u.pn < 18) { base = QKV; ldc = 4608; colt = u.pn * 256; }
        else if (u.pn < 44) { base = Z; ldc = 6656; colt = (u.pn - 18) * 256; }
        else { base = GT; ldc = 8192; colt = (u.pn - 44) * 256; sg = true; }
        const int col0 = colt + cl;
        f32x4 sv[2][2];
#pragma unroll
        for (int bj = 0; bj < 2; ++bj)
#pragma unroll
            for (int n = 0; n < 2; ++n) sv[bj][n] = *(const f32x4*)(sw + u.pn * BM + cl + bj * HALF + 4 * n);
        float rsv[2][4];
#pragma unroll
        for (int ai = 0; ai < 2; ++ai)
#pragma unroll
            for (int m = 0; m < 4; ++m) { const int r = row0 + ai * HALF + m * 16; rsv[ai][m] = rstd[r] * sx[r]; }
#pragma unroll
        for (int ai = 0; ai < 2; ++ai)
#pragma unroll
            for (int m = 0; m < 4; ++m) { const int r = row0 + ai * HALF + m * 16; const float rs = rsv[ai][m]; bf16_t* rowp = base + (size_t)r * ldc + col0;
#pragma unroll
                for (int bj = 0; bj < 2; ++bj) { f32x4 v0 = __builtin_convertvector(acc[ai][bj][m][0], f32x4) * rs * sv[bj][0], v1 = __builtin_convertvector(acc[ai][bj][m][1], f32x4) * rs * sv[bj][1];
                    if (sg) { v0 = sig4(v0); v1 = sig4(v1); }
                    *(u32x4*)(rowp + bj * HALF) = pack8(v0, v1); } }
    }
};
struct EpiMlp8 {
    static constexpr bool PERM = true, AFTER_DRAIN = false;
    bf16_t* O; int ldc; const float* ss; const float* sx; const float* sw;
    __device__ __forceinline__ void operator()(const i32x4 (&acc)[2][2][4][2], const Unit& u, int wr, int wc, int fr, int fq) const {
        const int row0 = u.pm * BM + wr * 64 + fr, col0 = u.pn * BM + wc * 32 + 8 * fq;
        f32x4 sv[2][2];
#pragma unroll
        for (int bj = 0; bj < 2; ++bj)
#pragma unroll
            for (int n = 0; n < 2; ++n) sv[bj][n] = *(const f32x4*)(sw + col0 + bj * HALF + 4 * n);
        float rsv[2][4];
#pragma unroll
        for (int ai = 0; ai < 2; ++ai)
#pragma unroll
            for (int m = 0; m < 4; ++m) { const int r = row0 + ai * HALF + m * 16; rsv[ai][m] = __builtin_amdgcn_rsqf(ss[r] * (1.0f / 4096.0f) + 1e-6f) * sx[r]; }
#pragma unroll
        for (int ai = 0; ai < 2; ++ai)
#pragma unroll
            for (int m = 0; m < 4; ++m) { const int r = row0 + ai * HALF + m * 16; const float rs = rsv[ai][m]; bf16_t* rowp = O + (size_t)r * ldc + col0;
#pragma unroll
                for (int bj = 0; bj < 2; ++bj) { f32x4 v0 = __builtin_convertvector(acc[ai][bj][m][0], f32x4) * rs * sv[bj][0], v1 = __builtin_convertvector(acc[ai][bj][m][1], f32x4) * rs * sv[bj][1];
#pragma unroll
                    for (int j = 0; j < 4; ++j) { const float a = v0[j] > 0.f ? v0[j] : 0.f, b = v1[j] > 0.f ? v1[j] : 0.f; v0[j] = a * a; v1[j] = b * b; }
                    *(u32x4*)(rowp + bj * HALF) = pack8(v0, v1); } }
    }
};
struct EpiLora {
    static constexpr bool PERM = true, AFTER_DRAIN = false;
    bf16_t* EAG; const float* w0; const float* a0; size_t third_stride;
    __device__ __forceinline__ void operator()(AccRef acc, const Unit& u, int wr, int wc, int fr, int fq) const {
        const int row0 = u.pm * BM + wr * 64 + fr, third = u.pn >> 3, colt = (u.pn & 7) * 256;
        bf16_t* base = EAG + (size_t)third * third_stride;
        const int col0 = colt + wc * 32 + 8 * fq;
        const float* bvec = third == 0 ? w0 : a0;
        f32x4 bv[2][2];
#pragma unroll
        for (int bj = 0; bj < 2; ++bj)
#pragma unroll
            for (int n = 0; n < 2; ++n) bv[bj][n] = third < 2 ? *(const f32x4*)(bvec + col0 + bj * HALF + 4 * n) : (f32x4){0.f, 0.f, 0.f, 0.f};
        const float mul = third == 0 ? 0.6065306597126334f : 1.0f;
#pragma unroll
        for (int ai = 0; ai < 2; ++ai)
#pragma unroll
            for (int m = 0; m < 4; ++m) { const int r = row0 + ai * HALF + m * 16; bf16_t* rowp = base + (size_t)r * 2048 + col0;
#pragma unroll
                for (int bj = 0; bj < 2; ++bj) { f32x4 v0 = acc[ai][bj][m][0] + bv[bj][0], v1 = acc[ai][bj][m][1] + bv[bj][1];
                    if (third < 2) { v0 = sig4(v0) * mul; v1 = sig4(v1) * mul; }
                    *(u32x4*)(rowp + bj * HALF) = pack8(v0, v1); } }
    }
};
template <int MODE> struct EpiB {
    static constexpr bool PERM = true, AFTER_DRAIN = false;
    bf16_t* O; int ldc; const float* rstd; const bf16_t* GT; const bf16_t* AD; unsigned* RM;
    struct RowIn { u32x4 g[2], a[2]; };
    __device__ __forceinline__ void load_row(RowIn& R, int r, int col0) const {
#pragma unroll
        for (int bj = 0; bj < 2; ++bj) {
            if (MODE == 2) R.g[bj] = *(const u32x4*)(GT + (size_t)r * 8192 + col0 + bj * HALF);
            if (MODE == 3) { R.g[bj] = *(const u32x4*)(GT + (size_t)r * 8192 + 4096 + col0 + bj * HALF); R.a[bj] = *(const u32x4*)(AD + (size_t)r * 4096 + col0 + bj * HALF); } }
    }
    __device__ __forceinline__ void operator()(AccRef acc, const Unit& u, int wr, int wc, int fr, int fq) const {
        const int row0 = u.pm * BM + wr * 64 + fr, col0 = u.pn * BM + wc * 32 + 8 * fq;
        RowIn cur, nxt;
        if (MODE >= 2) load_row(cur, row0, col0);
#pragma unroll
        for (int s = 0; s < 8; ++s) { const int ai = s >> 2, m = s & 3; const int r = row0 + ai * HALF + m * 16; bf16_t* rowp = O + (size_t)r * ldc + col0;
                if (MODE >= 2 && s + 1 < 8) load_row(nxt, row0 + ((s + 1) >> 2) * HALF + ((s + 1) & 3) * 16, col0);
                float rs = 1.f; if (MODE == 1) rs = __builtin_amdgcn_rsqf(rstd[r] * (1.0f / 4096.0f) + 1e-6f);
                float mx = 0.f;
#pragma unroll
                for (int bj = 0; bj < 2; ++bj) { f32x4 v0 = acc[ai][bj][m][0], v1 = acc[ai][bj][m][1];
                    if (MODE == 1) { v0 = v0 * rs; v1 = v1 * rs;
#pragma unroll
                        for (int j = 0; j < 4; ++j) { const float a = v0[j] > 0.f ? v0[j] : 0.f, b = v1[j] > 0.f ? v1[j] : 0.f; v0[j] = a * a; v1[j] = b * b; } }
                    if (MODE == 2) { f32x4 g0, g1; unpack8(cur.g[bj], g0, g1); v0 = v0 * g0; v1 = v1 * g1; }
                    if (MODE == 3) { f32x4 g0, g1, a0, a1; unpack8(cur.g[bj], g0, g1); unpack8(cur.a[bj], a0, a1);
                        v0 = a0 + v0 * g0; v1 = a1 + v1 * g1;
#pragma unroll
                        for (int j = 0; j < 4; ++j) mx = fmaxf(mx, fmaxf(fabsf(v0[j]), fabsf(v1[j]))); }
                    *(u32x4*)(rowp + bj * HALF) = pack8(v0, v1); }
                if (MODE == 3) { mx = fmaxf(mx, __shfl_xor(mx, 16)); mx = fmaxf(mx, __shfl_xor(mx, 32)); if (fq == 0) atomicMax(RM + r, __builtin_bit_cast(unsigned, mx)); }
                if (MODE >= 2) cur = nxt; }
    }
};
template <int MODE, bool I8 = false> struct EpiF {
    static constexpr bool PERM = false, AFTER_DRAIN = false;
    const float* res; float* out; const float* rstd; const bf16_t* PP; bf16_t* XB; float* SS; unsigned* RM;
    const float* sxr; const float* swc;
    struct RowIn { f32x4 b[2][2]; u32x2 pw[2][2]; };
    __device__ __forceinline__ void load_row(RowIn& R, size_t off) const {
#pragma unroll
        for (int bj = 0; bj < 2; ++bj)
#pragma unroll
            for (int n = 0; n < 2; ++n) { const size_t o = off + bj * HALF + n * 16; R.b[bj][n] = *(const f32x4*)(res + o); if (MODE == 1) R.pw[bj][n] = *(const u32x2*)(PP + o); }
    }
    __device__ __forceinline__ void operator()(const typename AccT<I8>::type (&acc)[2][2][4][2], const Unit& u, int wr, int wc, int fr, int fq) const {
        const int row0 = u.pm * BM + wr * 64 + fr, col0 = u.pn * BM + wc * 32 + 4 * fq;
        f32x4 sv[2][2];
        if (I8) {
#pragma unroll
            for (int bj = 0; bj < 2; ++bj)
#pragma unroll
                for (int n = 0; n < 2; ++n) sv[bj][n] = *(const f32x4*)(swc + col0 + bj * HALF + n * 16);
        }
        float rsv[8];
#pragma unroll
        for (int s = 0; s < 8; ++s) { const int r = row0 + (s >> 2) * HALF + (s & 3) * 16; float rs = 1.f; if (MODE == 1) rs = __builtin_amdgcn_rsqf(rstd[r] * (1.0f / 4096.0f) + 1e-6f); if (I8) rs *= sxr[r]; rsv[s] = rs; }
        RowIn cur, nxt;
        load_row(cur, (size_t)row0 * 4096 + col0);
#pragma unroll
        for (int s = 0; s < 8; ++s) { const int ai = s >> 2, m = s & 3; const int r = row0 + ai * HALF + m * 16; const size_t off = (size_t)r * 4096 + col0;
                if (s + 1 < 8) load_row(nxt, (size_t)(row0 + ((s + 1) >> 2) * HALF + ((s + 1) & 3) * 16) * 4096 + col0);
                const float rs = rsv[s];
                float ss = 0.f, mx = 0.f;
#pragma unroll
                for (int bj = 0; bj < 2; ++bj)
#pragma unroll
                    for (int n = 0; n < 2; ++n) { const size_t o = off + bj * HALF + n * 16; const f32x4 b = cur.b[bj][n]; f32x4 v;
                        if constexpr (I8) v = __builtin_convertvector(acc[ai][bj][m][n], f32x4) * rs * sv[bj][n]; else v = acc[ai][bj][m][n];
                        if (MODE == 1) { const u32x2 pw = cur.pw[bj][n]; const f32x4 pp = (f32x4){bf_lo(pw.x), bf_hi(pw.x), bf_lo(pw.y), bf_hi(pw.y)}; v = sig4(I8 ? v : v * rs) * pp; }
                        const f32x4 x = b + v; *(f32x4*)(out + o) = x;
                        if (MODE == 0 && XB) { u32x2 w; w.x = cvt_pk_bf16(x[0], x[1]); w.y = cvt_pk_bf16(x[2], x[3]); *(u32x2*)(XB + o) = w; ss += (x[0] * x[0] + x[1] * x[1]) + (x[2] * x[2] + x[3] * x[3]);
                            if (RM) mx = fmaxf(fmaxf(mx, fmaxf(fabsf(x[0]), fabsf(x[1]))), fmaxf(fabsf(x[2]), fabsf(x[3]))); } }
                if (MODE == 0 && XB) { ss += __shfl_xor(ss, 16); ss += __shfl_xor(ss, 32); if (fq == 0) unsafeAtomicAdd(SS + r, ss);
                    if (RM) { mx = fmaxf(mx, __shfl_xor(mx, 16)); mx = fmaxf(mx, __shfl_xor(mx, 32)); if (fq == 0) atomicMax(RM + r, __builtin_bit_cast(unsigned, mx)); } }
                cur = nxt; }
    }
};
}
constexpr int NWAVES = 8;
constexpr int SEQ = 4096, M = 16384, D = 4096;
constexpr int NQKV = 4608, NZP = 6656, NGT = 8192, NINP = 19456, NIN = 19392, NINA = 11264;
constexpr int RWW = 2048, DFF = 16384, PLE = 256, AOW = 512, LORAK = 512, LORAN = 6144;
#ifndef MK_ONE_LAUNCH
#define MK_ONE_LAUNCH 1
#endif
constexpr int NPH = 15;
enum { P_PRO = 0, G_WIN, T_ATTN, G_LORA, T_SCAN, T_CARRY, T_FIX, G_ATTUP, G_RWUP, G_OUT, T_N2, G_MLPIN, G_MLPOUT, G_PP, G_PLE };

constexpr size_t MiB = 1u << 20;
constexpr size_t WS_CTL = 0, CTL_ZERO_BYTES = 1 * MiB;
constexpr size_t WS_WIN = 2 * MiB;
constexpr size_t WS_WMLPIN = 2 * MiB;
constexpr size_t WS_WATT = 154 * MiB;
constexpr size_t WS_WLORA = 158 * MiB;
constexpr size_t WS_WRW = 164 * MiB;
constexpr size_t WS_WOUT = 180 * MiB;
constexpr size_t WS_XB = 212 * MiB;
constexpr size_t WS_QKV = 340 * MiB;
constexpr size_t WS_AD = 340 * MiB;
constexpr size_t WS_Z = 484 * MiB;
constexpr size_t WS_MERGED = 484 * MiB;
constexpr size_t WS_GT = 692 * MiB;
constexpr size_t WS_ATT = 948 * MiB;
constexpr size_t WS_RW = 964 * MiB;
constexpr size_t WS_EAG = 1028 * MiB;
constexpr size_t WS_ALORA = 1220 * MiB;
constexpr size_t WS_RSTD = 1236 * MiB;
constexpr size_t WS_PB = 1237 * MiB;
constexpr size_t WS_HID = 340 * MiB;
constexpr size_t WS_WMLPOUT = 852 * MiB;
constexpr size_t WS_WPLEG = 980 * MiB;
constexpr size_t WS_WPLEP = 1012 * MiB;
constexpr size_t WS_PP = 1014 * MiB;
constexpr size_t WS_YLOC = 212 * MiB;
constexpr size_t WS_GBUF = 340 * MiB;
constexpr size_t WS_LST = 130 * MiB;
constexpr size_t WS_TST = 1220 * MiB;
constexpr size_t WS_RKB = 146 * MiB;
constexpr size_t WS_OG = 964 * MiB;
constexpr size_t WS_LSE = 1012 * MiB;
constexpr size_t WS_WIN8 = 2 * MiB;
constexpr size_t WS_WZT = 78 * MiB;
constexpr size_t WS_X8 = 1028 * MiB;
constexpr size_t WS_SX = 1236 * MiB + 256 * 1024, WS_SW = 1236 * MiB + 384 * 1024;
constexpr size_t WS_W8M = 2 * MiB;
constexpr size_t WS_X8B = 130 * MiB;
constexpr size_t WS_SWM = 1236 * MiB + 512 * 1024, WS_SX2 = 1236 * MiB + 576 * 1024;
constexpr size_t WS_W8O = 180 * MiB;
constexpr size_t WS_W8P = 980 * MiB;
constexpr size_t WS_X8C = 340 * MiB;
constexpr size_t WS_X8D = 130 * MiB;
constexpr size_t WS_SWO = 1236 * MiB + 640 * 1024, WS_SWP = 1236 * MiB + 656 * 1024, WS_SX3 = 1236 * MiB + 704 * 1024, WS_SX4 = 1236 * MiB + 768 * 1024;
constexpr size_t WS_END = 1245 * MiB;
constexpr int CW_BAR = 4096;
constexpr size_t CTL_CMAX = 512 * 1024;
constexpr size_t CTL_RMAX2 = 704 * 1024;
constexpr size_t CTL_RMAX3 = 768 * 1024, CTL_RMAX4 = 832 * 1024;
constexpr size_t CTL_CMAXO = 896 * 1024, CTL_CMAXP = 912 * 1024;
constexpr size_t CTL_QCNT = 944 * 1024;
constexpr size_t CTL_SS2 = 256 * 1024, CTL_SS3 = 384 * 1024;

constexpr int RING_OFF = 0, RING_BYTES = 131072;
constexpr int LDSCTL_OFF = 163328, MISC_OFF = LDSCTL_OFF + 320;
constexpr int LDS_BYTES = 163840;

#define GAS __attribute__((address_space(1)))
#define LAS __attribute__((address_space(3)))
typedef unsigned short bf16;
typedef unsigned v4u __attribute__((ext_vector_type(4)));
typedef unsigned v2u __attribute__((ext_vector_type(2)));
typedef unsigned u32x4_t __attribute__((ext_vector_type(4)));
typedef float f32x4 __attribute__((ext_vector_type(4)));
typedef GAS unsigned gu32;
#define RLX_AGENT __ATOMIC_RELAXED, __HIP_MEMORY_SCOPE_AGENT
#define LDS_WAIT() asm volatile("s_waitcnt lgkmcnt(0)" ::: "memory")
__device__ __forceinline__ unsigned pk2(float lo, float hi) { return pg8::cvt_pk_bf16_n(lo, hi); }
__device__ __forceinline__ unsigned f2bf(float f) { return pg8::cvt_pk_bf16_n(f, 0.f) & 0xffffu; }
__device__ __forceinline__ float blo(unsigned w) { return __builtin_bit_cast(float, w << 16); }
__device__ __forceinline__ float bhi(unsigned w) { return __builtin_bit_cast(float, w & 0xffff0000u); }
__device__ __forceinline__ float bf1(bf16 h) { return __builtin_bit_cast(float, (unsigned)h << 16); }

template <int CTRL> __device__ __forceinline__ float dppf(float v) { return __builtin_bit_cast(float, __builtin_amdgcn_update_dpp(0, __builtin_bit_cast(int, v), CTRL, 0xf, 0xf, true)); }
__device__ __forceinline__ float red8(float v) { v += dppf<0xB1>(v); v += dppf<0x4E>(v); v += dppf<0x141>(v); return v; }
__device__ __forceinline__ float wave_sum_dpp(float v) {
    v += dppf<0xB1>(v); v += dppf<0x4E>(v); v += dppf<0x141>(v); v += dppf<0x140>(v);
    v += __builtin_bit_cast(float, __builtin_amdgcn_update_dpp(0, __builtin_bit_cast(int, v), 0x142, 0xa, 0xf, false));
    v += __builtin_bit_cast(float, __builtin_amdgcn_update_dpp(0, __builtin_bit_cast(int, v), 0x143, 0xc, 0xf, false));
    return __builtin_bit_cast(float, __builtin_amdgcn_readlane(__builtin_bit_cast(int, v), 63));
}

#define WG_BAR_LDS() do { asm volatile("s_waitcnt lgkmcnt(0)" ::: "memory"); __builtin_amdgcn_s_barrier(); asm volatile("" ::: "memory"); } while (0)
#define XB_TMO      128
#define XB_XCNT(j)  (256  + 64 * (j))
#define XB_XSUB(j)  (1280 + 64 * (j))
#define XB_XGEN(j)  (2304 + 64 * (j))
#define XB_TOP      3328
#define XB_TOPGEN   3392
#define XCD_BAR_WORDS 3456
#define XB_SPIN_CAP (1u << 18)

__device__ __forceinline__ unsigned xb_ld(unsigned* p)              { return __hip_atomic_load(p, __ATOMIC_RELAXED, __HIP_MEMORY_SCOPE_AGENT); }
__device__ __forceinline__ unsigned xb_add(unsigned* p, unsigned v) { return __hip_atomic_fetch_add(p, v, __ATOMIC_RELAXED, __HIP_MEMORY_SCOPE_AGENT); }
__device__ __forceinline__ unsigned xb_xcc_id() { return (unsigned)__builtin_amdgcn_s_getreg((3 << 11) | 20) & 0xFu; }
#define XB_SPIN(cond, bar) do { unsigned _sp = 0; while (cond) { __builtin_amdgcn_s_sleep(1); \
    if ((++_sp & 255u) == 0u) { if (xb_ld(&(bar)[XB_TMO])) break; if (_sp > XB_SPIN_CAP) { atomicAdd(&(bar)[XB_TMO], 1u); break; } } } } while (0)

struct XcdBarrier {
    unsigned* bar; unsigned x;
    volatile LAS unsigned* st;
};

__device__ __forceinline__ XcdBarrier xcd_barrier_post(unsigned* bar, volatile LAS unsigned* st) {
    XcdBarrier b; b.bar = bar; b.x = xb_xcc_id(); b.st = st;
    if (threadIdx.x == 0) (void)xb_add(&bar[XB_XCNT(b.x)], 1u);
    return b;
}
__device__ __forceinline__ void xcd_barrier_complete(unsigned* bar, unsigned x, unsigned& nloc, unsigned& nx) {
    const unsigned G = gridDim.x * gridDim.y * gridDim.z;
    unsigned sum, cnt, mine, sp = 0u;
    for (;;) {
        sum = 0u; cnt = 0u; mine = 0u;
#pragma unroll
        for (unsigned j = 0; j < 16; ++j) { const unsigned c = xb_ld(&bar[XB_XCNT(j)]); sum += c; cnt += (c > 0u) ? 1u : 0u; mine = (j == x) ? c : mine; }
        if (sum == G) break;
        __builtin_amdgcn_s_sleep(1);
        if ((++sp & 255u) == 0u) { if (xb_ld(&bar[XB_TMO])) break; if (sp > XB_SPIN_CAP) { atomicAdd(&bar[XB_TMO], 1u); break; } }
    }
    nloc = mine > 0u ? mine : 1u; nx = cnt > 0u ? cnt : 1u;
}

__device__ __forceinline__ void xcd_barrier(const XcdBarrier& b) {
    asm volatile("s_waitcnt vmcnt(0)" ::: "memory");
    __syncthreads();
    if (threadIdx.x == 0) {
        unsigned* bar = b.bar;
        __builtin_amdgcn_s_waitcnt(0);
        unsigned nloc = b.st[0], nx = b.st[1];
        if (nloc == 0u) { xcd_barrier_complete(bar, b.x, nloc, nx); b.st[0] = nloc; b.st[1] = nx; }
        const unsigned old = xb_add(&bar[XB_XSUB(b.x)], 1u);
        const unsigned gen = old / nloc;
        if (old + 1u == (gen + 1u) * nloc) {
            __builtin_amdgcn_fence(__ATOMIC_RELEASE, "agent");
            asm volatile("s_waitcnt vmcnt(0)" ::: "memory");
            const unsigned og = xb_add(&bar[XB_TOP], 1u);
            const unsigned tg = og / nx;
            if (og + 1u == (tg + 1u) * nx) xb_add(&bar[XB_TOPGEN], 1u);
            else XB_SPIN(xb_ld(&bar[XB_TOPGEN]) == tg, bar);
            __builtin_amdgcn_fence(__ATOMIC_ACQUIRE, "agent");
            xb_add(&bar[XB_XGEN(b.x)], 1u);
            asm volatile("s_waitcnt vmcnt(0)" ::: "memory");
        } else {
            XB_SPIN(xb_ld(&bar[XB_XGEN(b.x)]) == gen, bar);
            __builtin_amdgcn_fence(__ATOMIC_ACQUIRE, "agent");
            asm volatile("s_waitcnt vmcnt(0)" ::: "memory");
        }
    }
    __syncthreads();
}
struct Frame {
    LAS unsigned char* lds;
    volatile LAS unsigned* MISC;
    gu32* ctl;
    int tid, lane, wave;
    int vcu, G;
    const float* in[27];
    float* out;
    unsigned char* ws;
};
__device__ __forceinline__ float wave_sum(float v) {
#pragma unroll
    for (int o = 1; o < 64; o <<= 1) v += __shfl_xor(v, o);
    return v;
}
struct TrTile { f32x4 v[16]; float g[16]; };
__device__ __forceinline__ void tr_load(TrTile& T, const float* W, int N, int nb0, int nblk, int item, int lane, const float* gk = nullptr) {
    const int kb = item / nblk, nb = nb0 + item % nblk, k0 = 64 * kb, n0 = 64 * nb, lr = lane >> 4, lc = lane & 15;
#pragma unroll
    for (int i = 0; i < 16; ++i) T.g[i] = gk ? gk[k0 + 4 * i + lr] : 1.0f;
#pragma unroll
    for (int i = 0; i < 16; ++i) T.v[i] = __builtin_nontemporal_load((const f32x4*)(W + (size_t)(k0 + 4 * i + lr) * N + n0 + 4 * lc));
}
__device__ __forceinline__ void tr_store(const TrTile& T, int K, int nb0, int nblk, bf16* WT, const float* gk, int pad_from, int pad, LAS float* scr, int item, int lane) {
    const int kb = item / nblk, nb = nb0 + item % nblk, k0 = 64 * kb, n0 = 64 * nb, lr = lane >> 4, lc = lane & 15;
#pragma unroll
    for (int i = 0; i < 16; ++i) { const float g = T.g[i]; LAS float* s = scr + (4 * i + lr) * 65 + 4 * lc; s[0] = T.v[i].x * g; s[1] = T.v[i].y * g; s[2] = T.v[i].z * g; s[3] = T.v[i].w * g; }
    LDS_WAIT(); asm volatile("" ::: "memory");
    const int c = lane & 7, roff = n0 >= pad_from ? pad : 0;
#pragma unroll
    for (int j = 0; j < 8; ++j) { const int n = (lane >> 3) + 8 * j; const LAS float* s = scr + (8 * c) * 65 + n;
        v4u o; o.x = pk2(s[0 * 65], s[1 * 65]); o.y = pk2(s[2 * 65], s[3 * 65]); o.z = pk2(s[4 * 65], s[5 * 65]); o.w = pk2(s[6 * 65], s[7 * 65]);
        *(v4u*)(WT + (size_t)(roff + n0 + n) * K + k0 + 8 * c) = o; }
    LDS_WAIT(); asm volatile("" ::: "memory");
}
__device__ __forceinline__ void transpose_item_lowreg(const float* W, int K, int N, bf16* WT, const float* gk, LAS float* scr, int item, int lane) {
    const int nblk = N / 64, kb = item / nblk, nb = item % nblk, k0 = 64 * kb, n0 = 64 * nb, lr = lane >> 4, lc = lane & 15;
#pragma unroll 1
    for (int ig = 0; ig < 4; ++ig) { f32x4 v[4];
#pragma unroll
        for (int i = 0; i < 4; ++i) v[i] = *(const f32x4*)(W + (size_t)(k0 + 16 * ig + 4 * i + lr) * N + n0 + 4 * lc);
#pragma unroll
        for (int i = 0; i < 4; ++i) { const float g = gk[k0 + 16 * ig + 4 * i + lr]; LAS float* s = scr + (16 * ig + 4 * i + lr) * 65 + 4 * lc; s[0] = v[i].x * g; s[1] = v[i].y * g; s[2] = v[i].z * g; s[3] = v[i].w * g; } }
    LDS_WAIT(); asm volatile("" ::: "memory");
    const int c = lane & 7;
#pragma unroll 1
    for (int j = 0; j < 8; ++j) { const int n = (lane >> 3) + 8 * j; const LAS float* s = scr + (8 * c) * 65 + n;
        v4u o; o.x = pk2(s[0 * 65], s[1 * 65]); o.y = pk2(s[2 * 65], s[3 * 65]); o.z = pk2(s[4 * 65], s[5 * 65]); o.w = pk2(s[6 * 65], s[7 * 65]);
        *(v4u*)(WT + (size_t)(n0 + n) * K + k0 + 8 * c) = o; }
    LDS_WAIT(); asm volatile("" ::: "memory");
}
__device__ __forceinline__ void transpose_matrix(Frame& F, const float* W, int K, int N, bf16* WT, const float* gk, int pad_from, int pad, int nb0 = 0, int nblk = -1, int rank = -1, int nrank = 0) {
    if (nblk < 0) nblk = N / 64;
    if (rank < 0) { rank = F.vcu; nrank = F.G; }
    LAS float* scr = (LAS float*)(F.lds + RING_OFF + F.wave * 16640);
    const int gw = rank * NWAVES + F.wave, NGW = nrank * NWAVES, nitems = (K / 64) * nblk;
    TrTile A, B; int it = gw;
    if (it < nitems) tr_load(A, W, N, nb0, nblk, it, F.lane, gk);
    while (it < nitems) {
        const int itb = it + NGW;
        if (itb < nitems) tr_load(B, W, N, nb0, nblk, itb, F.lane, gk);
        tr_store(A, K, nb0, nblk, WT, gk, pad_from, pad, scr, it, F.lane);
        if (itb >= nitems) break;
        it = itb + NGW;
        if (it < nitems) tr_load(A, W, N, nb0, nblk, it, F.lane, gk);
        tr_store(B, K, nb0, nblk, WT, gk, pad_from, pad, scr, itb, F.lane);
    }
}
__device__ __forceinline__ void colmax_sweep(Frame& F, const float* W, int K, int N, const float* gk, unsigned* cmax, int skip_from, int skip_cnt, int pad_from, int rank, int nrank) {
    const int lane = F.lane, lr = lane >> 4, lc = lane & 15, wave = F.wave, nblk = N / 64, nbe = nblk - skip_cnt; LAS float* red = (LAS float*)(F.lds + RING_OFF);
    for (int it = rank; it < nbe * 4; it += nrank) { const int eb = it % nbe, kq = it / nbe, nbr = eb < skip_from ? eb : eb + skip_cnt;
        f32x4 m = (f32x4){0.f, 0.f, 0.f, 0.f};
#pragma unroll
        for (int h = 0; h < 2; ++h) { const int kb = kq * 16 + wave * 2 + h; TrTile T; tr_load(T, W, N, 0, nblk, kb * nblk + nbr, lane); const int k0 = 64 * kb;
#pragma unroll
            for (int i = 0; i < 16; ++i) { const float g = gk ? gk[k0 + 4 * i + lr] : 1.0f; m.x = fmaxf(m.x, fabsf(T.v[i].x * g)); m.y = fmaxf(m.y, fabsf(T.v[i].y * g)); m.z = fmaxf(m.z, fabsf(T.v[i].z * g)); m.w = fmaxf(m.w, fabsf(T.v[i].w * g)); } }
#pragma unroll
        for (int e = 0; e < 4; ++e) { float v = m[e]; v = fmaxf(v, __shfl_xor(v, 16)); v = fmaxf(v, __shfl_xor(v, 32)); m[e] = v; }
        __syncthreads();
        if (lr == 0) *(LAS f32x4*)(red + wave * 64 + 4 * lc) = m;
        __syncthreads();
        if (wave == 0) { float v = red[lane];
#pragma unroll
            for (int w = 1; w < NWAVES; ++w) v = fmaxf(v, red[w * 64 + lane]);
            const int n = nbr * 64 + lane;
            atomicMax(cmax + n + (n >= pad_from ? 64 : 0), __builtin_bit_cast(unsigned, v)); }
    }
}
__device__ __forceinline__ unsigned q8(float x) { return (unsigned)(int)__builtin_rintf(x) & 0xffu; }
struct TrTileQ { f32x4 v[16]; };
__device__ __forceinline__ void trq_load(TrTileQ& T, const float* W, int N, int col0, int nblk32, int item, int lane) {
    const int kb = item / nblk32, nbr = item % nblk32, k0 = 128 * kb, n0 = col0 + 32 * nbr;
#pragma unroll
    for (int i = 0; i < 16; ++i) T.v[i] = __builtin_nontemporal_load((const f32x4*)(W + (size_t)(k0 + 8 * i + (lane >> 3)) * N + n0 + 4 * (lane & 7)));
}
__device__ __forceinline__ void trq_store(const TrTileQ& T, int K, int nblk32, signed char* W8, const float* gk, const unsigned* cmax, float* sw, LAS float* scr, int item, int lane) {
    const int kb = item / nblk32, nbr = item % nblk32, k0 = 128 * kb, n0 = 32 * nbr;
#pragma unroll
    for (int i = 0; i < 16; ++i) { const int row = 8 * i + (lane >> 3); const float g = gk[k0 + row]; LAS float* s = scr + row * 33 + 4 * (lane & 7); s[0] = T.v[i].x * g; s[1] = T.v[i].y * g; s[2] = T.v[i].z * g; s[3] = T.v[i].w * g; }
    LDS_WAIT(); asm volatile("" ::: "memory");
    const int c = lane & 7;
#pragma unroll
    for (int j = 0; j < 4; ++j) { const int n = (lane >> 3) + 8 * j; const LAS float* s = scr + (16 * c) * 33 + n;
        const float cm = __builtin_bit_cast(float, cmax[n0 + n]), inv = cm > 0.f ? 127.0f / cm : 0.f;
        v4u o;
        o.x = q8(s[0 * 33] * inv) | (q8(s[1 * 33] * inv) << 8) | (q8(s[2 * 33] * inv) << 16) | (q8(s[3 * 33] * inv) << 24);
        o.y = q8(s[4 * 33] * inv) | (q8(s[5 * 33] * inv) << 8) | (q8(s[6 * 33] * inv) << 16) | (q8(s[7 * 33] * inv) << 24);
        o.z = q8(s[8 * 33] * inv) | (q8(s[9 * 33] * inv) << 8) | (q8(s[10 * 33] * inv) << 16) | (q8(s[11 * 33] * inv) << 24);
        o.w = q8(s[12 * 33] * inv) | (q8(s[13 * 33] * inv) << 8) | (q8(s[14 * 33] * inv) << 16) | (q8(s[15 * 33] * inv) << 24);
        *(v4u*)(W8 + (size_t)(n0 + n) * K + k0 + 16 * c) = o;
        if (kb == 0 && c == 0) sw[n0 + n] = cm * (1.0f / 127.0f); }
    LDS_WAIT(); asm volatile("" ::: "memory");
}
__device__ __forceinline__ void quantize_matrix(Frame& F, const float* W, int K, int N, signed char* W8, const float* gk, const unsigned* cmax, float* sw, int skip_from, int skip_cnt, int pad_from) {
    const int gw = F.vcu * NWAVES + F.wave, NGW = F.G * NWAVES, nbe = N / 64 - skip_cnt, nitems = (K / 128) * nbe, lane = F.lane;
    for (int it = gw; it < nitems; it += NGW) {
        const int kb = it / nbe, eb = it % nbe, nbr = eb < skip_from ? eb : eb + skip_cnt, k0 = 128 * kb, n = 64 * nbr + lane, dr = n + (n >= pad_from ? 64 : 0);
        const float cm = __builtin_bit_cast(float, cmax[dr]), inv = cm > 0.f ? 127.0f / cm : 0.f;
        const float* src = W + (size_t)k0 * N + n;
#pragma unroll 2
        for (int c = 0; c < 8; ++c) { unsigned o[4];
#pragma unroll
            for (int wq = 0; wq < 4; ++wq) { unsigned a = 0;
#pragma unroll
                for (int bq = 0; bq < 4; ++bq) { const int k = 16 * c + 4 * wq + bq; a |= q8(src[(size_t)k * N] * (gk ? gk[k0 + k] : 1.0f) * inv) << (8 * bq); }
                o[wq] = a; }
            *(v4u*)(W8 + (size_t)dr * K + k0 + 16 * c) = (v4u){o[0], o[1], o[2], o[3]}; }
        if (kb == 0) sw[dr] = cm * (1.0f / 127.0f);
    }
}
__device__ __forceinline__ void quantize_blocks_wg(Frame& F, const float* W, int N, const float* gk, signed char* W8, float* sw, int nblocks, int skip_from, int skip_cnt, int pad_from, int rank, int nrank) {
    constexpr int K = 4096;
    const int lane = F.lane, wave = F.wave, lr8 = lane >> 3, lc8 = lane & 7;
    LAS float* scr = (LAS float*)(F.lds + RING_OFF + wave * 16896); LAS float* red = (LAS float*)(F.lds + RING_OFF + 8 * 16896); LAS float* cmv = red + 8 * 32;
    for (int eb = rank; eb < nblocks; eb += nrank) { const int nb = eb < skip_from ? eb : eb + skip_cnt, dsh = (nb * 64 >= pad_from) ? 64 : 0;
#pragma unroll 1
        for (int h = 0; h < 2; ++h) {
            const int n0 = nb * 64 + 32 * h;
            f32x4 m = (f32x4){0.f, 0.f, 0.f, 0.f};
            for (int i = 0; i < 4; i += 2) { TrTileQ A, B; const int ka = 128 * (wave + 8 * i), kb = ka + 1024;
#pragma unroll
                for (int j = 0; j < 16; ++j) A.v[j] = *(const f32x4*)(W + (size_t)(ka + 8 * j + lr8) * N + n0 + 4 * lc8);
#pragma unroll
                for (int j = 0; j < 16; ++j) B.v[j] = *(const f32x4*)(W + (size_t)(kb + 8 * j + lr8) * N + n0 + 4 * lc8);
#pragma unroll
                for (int j = 0; j < 16; ++j) { const float g = gk ? gk[ka + 8 * j + lr8] : 1.0f; m.x = fmaxf(m.x, fabsf(A.v[j].x * g)); m.y = fmaxf(m.y, fabsf(A.v[j].y * g)); m.z = fmaxf(m.z, fabsf(A.v[j].z * g)); m.w = fmaxf(m.w, fabsf(A.v[j].w * g)); }
#pragma unroll
                for (int j = 0; j < 16; ++j) { const float g = gk ? gk[kb + 8 * j + lr8] : 1.0f; m.x = fmaxf(m.x, fabsf(B.v[j].x * g)); m.y = fmaxf(m.y, fabsf(B.v[j].y * g)); m.z = fmaxf(m.z, fabsf(B.v[j].z * g)); m.w = fmaxf(m.w, fabsf(B.v[j].w * g)); } }
#pragma unroll
            for (int e = 0; e < 4; ++e) { float v = m[e]; v = fmaxf(v, __shfl_xor(v, 8)); v = fmaxf(v, __shfl_xor(v, 16)); v = fmaxf(v, __shfl_xor(v, 32)); m[e] = v; }
            __syncthreads();
            if (lr8 == 0) *(LAS f32x4*)(red + wave * 32 + 4 * lc8) = m;
            __syncthreads();
            if (wave == 0 && lane < 32) { float v = red[lane];
#pragma unroll
                for (int w = 1; w < NWAVES; ++w) v = fmaxf(v, red[w * 32 + lane]);
                cmv[lane] = v; sw[n0 + lane + dsh] = v * (1.0f / 127.0f); }
            __syncthreads();
            TrTileQ T;
#pragma unroll
            for (int j = 0; j < 16; ++j) T.v[j] = *(const f32x4*)(W + (size_t)(128 * wave + 8 * j + lr8) * N + n0 + 4 * lc8);
            for (int i = 0; i < 4; ++i) { const int k0 = 128 * (wave + 8 * i);
#pragma unroll
                for (int j = 0; j < 16; ++j) { const int row = 8 * j + lr8; const float g = gk ? gk[k0 + row] : 1.0f; LAS float* s = scr + row * 33 + 4 * lc8; s[0] = T.v[j].x * g; s[1] = T.v[j].y * g; s[2] = T.v[j].z * g; s[3] = T.v[j].w * g; }
                if (i + 1 < 4) {
#pragma unroll
                    for (int j = 0; j < 16; ++j) T.v[j] = *(const f32x4*)(W + (size_t)(k0 + 1024 + 8 * j + lr8) * N + n0 + 4 * lc8); }
                LDS_WAIT(); asm volatile("" ::: "memory");
                const int c = lc8;
#pragma unroll
                for (int j = 0; j < 4; ++j) { const int n = lr8 + 8 * j; const LAS float* s = scr + (16 * c) * 33 + n;
                    const float cm = cmv[n], inv = cm > 0.f ? 127.0f / cm : 0.f;
                    v4u o;
                    o.x = q8(s[0 * 33] * inv) | (q8(s[1 * 33] * inv) << 8) | (q8(s[2 * 33] * inv) << 16) | (q8(s[3 * 33] * inv) << 24);
                    o.y = q8(s[4 * 33] * inv) | (q8(s[5 * 33] * inv) << 8) | (q8(s[6 * 33] * inv) << 16) | (q8(s[7 * 33] * inv) << 24);
                    o.z = q8(s[8 * 33] * inv) | (q8(s[9 * 33] * inv) << 8) | (q8(s[10 * 33] * inv) << 16) | (q8(s[11 * 33] * inv) << 24);
                    o.w = q8(s[12 * 33] * inv) | (q8(s[13 * 33] * inv) << 8) | (q8(s[14 * 33] * inv) << 16) | (q8(s[15 * 33] * inv) << 24);
                    *(v4u*)(W8 + (size_t)(n0 + n + dsh) * K + k0 + 16 * c) = o; }
                LDS_WAIT(); asm volatile("" ::: "memory"); }
            __syncthreads();
        }
    }
}
struct QTile { f32x4 v[16]; };
__device__ __forceinline__ void q16_load(QTile& T, const float* W, int N, int n0, int hb, int wave, int lane) {
    const unsigned off0 = ((unsigned)(hb * 2048 + wave * 16 + (lane >> 2)) * (unsigned)N + (unsigned)(n0 + 4 * (lane & 3))) * 4u, step = (unsigned)N * 512u;
#pragma unroll
    for (int i = 0; i < 16; ++i) T.v[i] = *(const f32x4*)((const char*)W + (off0 + (unsigned)i * step));
}
__device__ __forceinline__ void q16_image(const QTile& T, f32x4& m, const float* gk, LAS unsigned char* img, int hb, int wave, int lane) {
    const int r4 = lane >> 2, c4 = lane & 3;
#pragma unroll
    for (int i = 0; i < 16; ++i) { const int row = (hb * 16 + i) * 128 + wave * 16 + r4; const float g = gk ? gk[row] : 1.0f; const f32x4 x = T.v[i] * g;
        m.x = fmaxf(m.x, fabsf(x.x)); m.y = fmaxf(m.y, fabsf(x.y)); m.z = fmaxf(m.z, fabsf(x.z)); m.w = fmaxf(m.w, fabsf(x.w));
        v2u w; w.x = pk2(x.x, x.y); w.y = pk2(x.z, x.w); *(LAS v2u*)(img + row * 32 + (row >> 4) * 32 + c4 * 8) = w; }
}
__device__ __forceinline__ void quantize_cols16_wg(Frame& F, const float* W, int N, const float* gk, signed char* W8, float* sw, int nblocks, int skip_from, int skip_cnt, int pad_from, int rank, int nrank) {
    constexpr int K = 4096;
    const int lane = F.lane, wave = F.wave, r4 = lane >> 2, c4 = lane & 3;
    LAS unsigned char* img = F.lds + RING_OFF; LAS float* red = (LAS float*)(F.lds + RING_OFF + 139264); LAS float* cmv = red + 8 * 16;
    QTile A, B;
    for (int eb = rank; eb < nblocks; eb += nrank) {
        const int b16 = eb < skip_from ? eb : eb + skip_cnt, n0 = b16 * 16, dsh = (n0 >= pad_from) ? 64 : 0;
        f32x4 m = (f32x4){0.f, 0.f, 0.f, 0.f};
        q16_load(A, W, N, n0, 0, wave, lane);
        q16_load(B, W, N, n0, 1, wave, lane);
        q16_image(A, m, gk, img, 0, wave, lane);
        q16_image(B, m, gk, img, 1, wave, lane);
#pragma unroll
        for (int e = 0; e < 4; ++e) { float v = m[e]; v = fmaxf(v, __shfl_xor(v, 4)); v = fmaxf(v, __shfl_xor(v, 8)); v = fmaxf(v, __shfl_xor(v, 16)); v = fmaxf(v, __shfl_xor(v, 32)); m[e] = v; }
        if (r4 == 0) *(LAS f32x4*)(red + wave * 16 + 4 * c4) = m;
        WG_BAR_LDS();
        if (F.tid < 16) { float v = red[F.tid];
#pragma unroll
            for (int w = 1; w < NWAVES; ++w) v = fmaxf(v, red[w * 16 + F.tid]);
            cmv[F.tid] = v; sw[n0 + F.tid + dsh] = v * (1.0f / 127.0f); }
        WG_BAR_LDS();
        { const int n = lane & 15, kc = lane >> 4; const float cm = cmv[n], inv = cm > 0.f ? 127.0f / cm : 0.f;
#pragma unroll 2
            for (int it = 0; it < 8; ++it) { const int ch = (it * 8 + wave) * 4 + kc;
                const LAS bf16* s = (const LAS bf16*)(img + ch * 544) + n;
                unsigned o[4];
#pragma unroll
                for (int q = 0; q < 4; ++q) o[q] = q8(bf1(s[(4 * q) * 16]) * inv) | (q8(bf1(s[(4 * q + 1) * 16]) * inv) << 8) | (q8(bf1(s[(4 * q + 2) * 16]) * inv) << 16) | (q8(bf1(s[(4 * q + 3) * 16]) * inv) << 24);
                *(v4u*)(W8 + (size_t)(n0 + n + dsh) * K + ch * 16) = (v4u){o[0], o[1], o[2], o[3]}; } }
        WG_BAR_LDS();
    }
}
__device__ __forceinline__ void q32_pass2(LAS unsigned char* img, const LAS float* cmv, signed char* W8row0, int kbase, int wave, int lane) {
    const int n = lane & 31, kc = lane >> 5; const float cm = cmv[n], inv = cm > 0.f ? 127.0f / cm : 0.f;
#pragma unroll 2
    for (int it = 0; it < 8; ++it) { const int ch = (it * 8 + wave) * 2 + kc;
        const LAS bf16* s = (const LAS bf16*)(img + ch * 1088) + n;
        unsigned o[4];
#pragma unroll
        for (int q = 0; q < 4; ++q) o[q] = q8(bf1(s[(4 * q) * 32]) * inv) | (q8(bf1(s[(4 * q + 1) * 32]) * inv) << 8) | (q8(bf1(s[(4 * q + 2) * 32]) * inv) << 16) | (q8(bf1(s[(4 * q + 3) * 32]) * inv) << 24);
        *(v4u*)(W8row0 + (size_t)n * 4096 + kbase + ch * 16) = (v4u){o[0], o[1], o[2], o[3]}; }
}
__device__ __forceinline__ void quantize_cols32_wg(Frame& F, const float* W, int N, const float* gk, signed char* W8, float* sw, int nblocks, int skip_from, int skip_cnt, int pad_from, int rank, int nrank, unsigned* dyn = nullptr) {
    const int lane = F.lane, wave = F.wave, r8 = lane >> 3, c8 = lane & 7;
    LAS unsigned char* img = F.lds + RING_OFF; LAS float* red = (LAS float*)(F.lds + RING_OFF + 139264); LAS float* cmv = red + 8 * 32;
    LAS int* nxt = (LAS int*)(cmv + 32);
    for (int eb = rank; ; eb += nrank) {
        if (dyn) { if (F.tid == 0) *nxt = (int)atomicAdd(dyn, 1u); WG_BAR_LDS(); eb = *nxt; }
        if (eb >= nblocks) break;
        const int b32 = eb < skip_from ? eb : eb + skip_cnt, n0 = b32 * 32, dsh = (n0 >= pad_from) ? 64 : 0;
        const unsigned off0 = ((unsigned)(wave * 8 + r8) * (unsigned)N + (unsigned)(n0 + 4 * c8)) * 4u, step = (unsigned)N * 256u;
        f32x4 m = (f32x4){0.f, 0.f, 0.f, 0.f};
#pragma unroll 1
        for (int hb = 0; hb < 2; ++hb) { f32x4 v[16];
#pragma unroll
            for (int i = 0; i < 16; ++i) v[i] = *(const f32x4*)((const char*)W + (off0 + (unsigned)(hb * 16 + i) * step));
            float gv[16];
#pragma unroll
            for (int i = 0; i < 16; ++i) gv[i] = gk ? gk[(hb * 16 + i) * 64 + wave * 8 + r8] : 1.0f;
#pragma unroll
            for (int i = 0; i < 16; ++i) { const int lr = (hb * 16 + i) * 64 + wave * 8 + r8; const float g = gv[i]; const f32x4 x = v[i] * g;
                m.x = fmaxf(m.x, fabsf(x.x)); m.y = fmaxf(m.y, fabsf(x.y)); m.z = fmaxf(m.z, fabsf(x.z)); m.w = fmaxf(m.w, fabsf(x.w));
                v2u w; w.x = pk2(x.x, x.y); w.y = pk2(x.z, x.w); *(LAS v2u*)(img + lr * 64 + (lr >> 4) * 64 + c8 * 8) = w; } }
#pragma unroll 1
        for (int hb = 0; hb < 2; ++hb) { f32x4 v[16];
#pragma unroll
            for (int i = 0; i < 16; ++i) v[i] = *(const f32x4*)((const char*)W + (off0 + (unsigned)(32 + hb * 16 + i) * step));
            float gv[16];
#pragma unroll
            for (int i = 0; i < 16; ++i) gv[i] = gk ? gk[2048 + (hb * 16 + i) * 64 + wave * 8 + r8] : 1.0f;
#pragma unroll
            for (int i = 0; i < 16; ++i) { const float g = gv[i]; const f32x4 x = v[i] * g;
                m.x = fmaxf(m.x, fabsf(x.x)); m.y = fmaxf(m.y, fabsf(x.y)); m.z = fmaxf(m.z, fabsf(x.z)); m.w = fmaxf(m.w, fabsf(x.w)); } }
#pragma unroll
        for (int e = 0; e < 4; ++e) { float v = m[e]; v = fmaxf(v, __shfl_xor(v, 8)); v = fmaxf(v, __shfl_xor(v, 16)); v = fmaxf(v, __shfl_xor(v, 32)); m[e] = v; }
        if (r8 == 0) *(LAS f32x4*)(red + wave * 32 + 4 * c8) = m;
        WG_BAR_LDS();
        if (F.tid < 32) { float v = red[F.tid];
#pragma unroll
            for (int w = 1; w < NWAVES; ++w) v = fmaxf(v, red[w * 32 + F.tid]);
            cmv[F.tid] = v; sw[n0 + F.tid + dsh] = v * (1.0f / 127.0f); }
        WG_BAR_LDS();
        signed char* row0 = W8 + (size_t)(n0 + dsh) * 4096;
        q32_pass2(img, cmv, row0, 0, wave, lane);
        WG_BAR_LDS();
#pragma unroll 1
        for (int hb = 0; hb < 2; ++hb) { f32x4 v[16];
#pragma unroll
            for (int i = 0; i < 16; ++i) v[i] = *(const f32x4*)((const char*)W + (off0 + (unsigned)(32 + hb * 16 + i) * step));
            float gv[16];
#pragma unroll
            for (int i = 0; i < 16; ++i) gv[i] = gk ? gk[2048 + (hb * 16 + i) * 64 + wave * 8 + r8] : 1.0f;
#pragma unroll
            for (int i = 0; i < 16; ++i) { const int lr = (hb * 16 + i) * 64 + wave * 8 + r8; const float g = gv[i]; const f32x4 x = v[i] * g;
                v2u w; w.x = pk2(x.x, x.y); w.y = pk2(x.z, x.w); *(LAS v2u*)(img + lr * 64 + (lr >> 4) * 64 + c8 * 8) = w; } }
        WG_BAR_LDS();
        q32_pass2(img, cmv, row0, 2048, wave, lane);
        WG_BAR_LDS();
    }
}
__device__ __forceinline__ void rows_bf16_to_i8(Frame& F, const bf16* XBp, const unsigned* rmax, unsigned* X8, float* sx, int pitch4 = D / 4) {
    const int gw = F.vcu * NWAVES + F.wave, NGW = F.G * NWAVES, lane = F.lane;
    v4u w[8], wn[8]; unsigned rb = 0, rbn = 0;
    int m = gw;
    if (m < M) { const v4u* src = (const v4u*)(XBp + (size_t)m * D) + lane; rb = rmax[m];
#pragma unroll
        for (int j = 0; j < 8; ++j) w[j] = src[64 * j]; }
    for (; m < M; m += NGW) {
        const int mn = m + NGW;
        if (mn < M) { const v4u* src = (const v4u*)(XBp + (size_t)mn * D) + lane; rbn = rmax[mn];
#pragma unroll
            for (int j = 0; j < 8; ++j) wn[j] = src[64 * j]; }
        const float mx = __builtin_bit_cast(float, rb), inv = mx > 0.f ? 127.0f / mx : 0.f;
        v2u* dst = (v2u*)(X8 + (size_t)m * pitch4) + lane;
#pragma unroll
        for (int j = 0; j < 8; ++j) { v2u o;
            o.x = q8(blo(w[j].x) * inv) | (q8(bhi(w[j].x) * inv) << 8) | (q8(blo(w[j].y) * inv) << 16) | (q8(bhi(w[j].y) * inv) << 24);
            o.y = q8(blo(w[j].z) * inv) | (q8(bhi(w[j].z) * inv) << 8) | (q8(blo(w[j].w) * inv) << 16) | (q8(bhi(w[j].w) * inv) << 24);
            dst[64 * j] = o; }
        if (lane == 0) sx[m] = mx * (1.0f / 127.0f);
#pragma unroll
        for (int j = 0; j < 8; ++j) w[j] = wn[j];
        rb = rbn;
    }
}
struct RowTile { f32x4 v[16]; };
__device__ __forceinline__ void row_load(RowTile& R, const float* xrow, int lane) {
    const f32x4* xr = (const f32x4*)xrow + lane;
#pragma unroll
    for (int j = 0; j < 16; ++j) R.v[j] = __builtin_nontemporal_load(xr + 64 * j);
}
__device__ __forceinline__ void row_store(const RowTile& R, bf16* orow, float* rstd_out, unsigned* q8row, float* sx_out, int lane) {
    float s = 0.f, mx = 0.f;
#pragma unroll
    for (int j = 0; j < 16; ++j) { s += (R.v[j].x * R.v[j].x + R.v[j].y * R.v[j].y) + (R.v[j].z * R.v[j].z + R.v[j].w * R.v[j].w);
        mx = fmaxf(fmaxf(mx, fmaxf(fabsf(R.v[j].x), fabsf(R.v[j].y))), fmaxf(fabsf(R.v[j].z), fabsf(R.v[j].w))); }
    s = wave_sum(s);
    if (orow) { v2u* o8 = (v2u*)orow + lane;
#pragma unroll
        for (int j = 0; j < 16; ++j) { v2u w; w.x = pk2(R.v[j].x, R.v[j].y); w.y = pk2(R.v[j].z, R.v[j].w); o8[64 * j] = w; } }
    if (q8row) {
#pragma unroll
        for (int o = 1; o < 64; o <<= 1) mx = fmaxf(mx, __shfl_xor(mx, o));
        const float inv = mx > 0.f ? 127.0f / mx : 0.f;
#pragma unroll
        for (int j = 0; j < 16; ++j) q8row[lane + 64 * j] = q8(R.v[j].x * inv) | (q8(R.v[j].y * inv) << 8) | (q8(R.v[j].z * inv) << 16) | (q8(R.v[j].w * inv) << 24);
        if (lane == 0) *sx_out = mx * (1.0f / 127.0f);
    }
    if (lane == 0) *rstd_out = 1.0f / sqrtf(s * (1.0f / 4096.0f) + 1e-6f);
}
__device__ __forceinline__ void rows_to_bf16_rstd(Frame& F, const float* X, bf16* XB, float* rstd, unsigned* X8, float* sx) {
    const int gw = F.vcu * NWAVES + F.wave, NGW = F.G * NWAVES;
    RowTile A, B; int m = gw;
    if (m < M) row_load(A, X + (size_t)m * D, F.lane);
    while (m < M) {
        const int mb = m + NGW;
        if (mb < M) row_load(B, X + (size_t)mb * D, F.lane);
        row_store(A, XB ? XB + (size_t)m * D : nullptr, rstd + m, X8 ? X8 + (size_t)m * (D / 4) : nullptr, sx + m, F.lane);
        if (mb >= M) break;
        m = mb + NGW;
        if (m < M) row_load(A, X + (size_t)m * D, F.lane);
        row_store(B, XB ? XB + (size_t)mb * D : nullptr, rstd + mb, X8 ? X8 + (size_t)mb * (D / 4) : nullptr, sx + mb, F.lane);
    }
}

__device__ __forceinline__ void p_prologue(Frame& F) {
    unsigned char* ws = F.ws;
    int rq = F.vcu, nq = F.G, rc = F.vcu, nc = F.G;
    if (F.G == 256) { const int xl = F.vcu & 31, xq = F.vcu >> 5; if (xl < 25) { rq = xq * 25 + xl; nq = 200; rc = -1; } else { rc = xq * 7 + (xl - 25); nc = 56; rq = -1; } }
    if (rq >= 0) quantize_cols32_wg(F, F.in[3], NIN, F.in[2], (signed char*)(ws + WS_WIN8), (float*)(ws + WS_SW), 400, 144, 206, 11200, rq, nq);
    if (rc >= 0) {
        colmax_sweep(F, F.in[20], D, D, nullptr, (unsigned*)(ws + CTL_CMAXO), 1 << 30, 0, 1 << 30, rc, nc);
        colmax_sweep(F, F.in[25], D, D, F.in[24], (unsigned*)(ws + CTL_CMAXP), 1 << 30, 0, 1 << 30, rc, nc);
    }
    __syncthreads();
    rows_to_bf16_rstd(F, F.in[0], (bf16*)(ws + WS_XB), (float*)(ws + WS_RSTD), (unsigned*)(ws + WS_X8), (float*)(ws + WS_SX));
    { const size_t gt0 = (size_t)blockIdx.x * 512 + F.tid, NT0 = (size_t)F.G * 512;
      v4u* z = (v4u*)(ws + WS_WIN8 + (size_t)11200 * D); for (size_t i = gt0; i < (size_t)64 * D / 16; i += NT0) z[i] = (v4u){0u, 0u, 0u, 0u};
      if (gt0 < 64) ((float*)(ws + WS_SW))[11200 + gt0] = 0.f; }
    transpose_matrix(F, F.in[3], D, NIN, (bf16*)(ws + WS_WZT) - (size_t)4608 * D, F.in[2], 1 << 30, 0, 72, 103);
    { const size_t gt0 = (size_t)blockIdx.x * 512 + F.tid, NT0 = (size_t)F.G * 512; v4u* z = (v4u*)(ws + WS_WZT + (size_t)6592 * D * 2); for (size_t i = gt0; i < (size_t)64 * D / 8; i += NT0) z[i] = (v4u){0u, 0u, 0u, 0u}; }
    __syncthreads();
    const size_t gt = (size_t)blockIdx.x * 512 + F.tid, NT = (size_t)F.G * 512;
    {
        const float* wd = F.in[10]; const float* wa = F.in[12]; const float* wg = F.in[13]; bf16* WL = (bf16*)(ws + WS_WLORA);
        for (size_t i = gt; i < (size_t)LORAN * 64; i += NT) { const int n = (int)(i % LORAN), k8 = (int)(i / LORAN) * 8, third = n >> 11, c = n & 2047; float v[8];
#pragma unroll
            for (int j = 0; j < 8; ++j) { const int k = k8 + j; float x = 0.f;
                if (third == 0) { if (k < 96) x = wd[(size_t)k * 2048 + c]; }
                else if (third == 1) { if (k >= 96 && k < 192) x = wa[(size_t)(k - 96) * 2048 + c]; }
                else { if (k >= 192 && k < 448) x = wg[(size_t)(k - 192) * 2048 + c]; }
                v[j] = x; }
            v4u o; o.x = pk2(v[0], v[1]); o.y = pk2(v[2], v[3]); o.z = pk2(v[4], v[5]); o.w = pk2(v[6], v[7]);
            *(v4u*)(WL + (size_t)n * LORAK + k8) = o; } }
}

__device__ __forceinline__ void late_conversions(Frame& F, int rank, int nrank) {
    unsigned char* ws = F.ws;
    transpose_matrix(F, F.in[7], AOW, D, (bf16*)(ws + WS_WATT), nullptr, 1 << 30, 0, 0, -1, rank, nrank);
    transpose_matrix(F, F.in[19], RWW, D, (bf16*)(ws + WS_WRW), nullptr, 1 << 30, 0, 0, -1, rank, nrank);
    const size_t gt = (size_t)rank * 512 + F.tid, NT = (size_t)nrank * 512;
    const f32x4* p4 = (const f32x4*)F.in[1]; v2u* pb = (v2u*)(ws + WS_PB);
    for (size_t i = gt; i < (size_t)M * PLE / 4; i += NT) { const f32x4 v = p4[i]; v2u w; w.x = pk2(v.x, v.y); w.y = pk2(v.z, v.w); pb[i] = w; }
}
__device__ __forceinline__ void t_lora_in(Frame& F) {
    unsigned char* ws = F.ws;
    const bf16* Z = (const bf16*)(ws + WS_Z); bf16* AL = (bf16*)(ws + WS_ALORA);
    const float* mix = F.in[8];
    const int gw = F.vcu * NWAVES + F.wave, NGW = F.G * NWAVES, lane = F.lane;
    const int c = lane * 8; const bool act = lane < 56;
    float mx[8];
#pragma unroll
    for (int j = 0; j < 8; ++j) mx[j] = act ? mix[6144 + c + j] : 0.f;
    v4u w = (v4u){0u, 0u, 0u, 0u}, wp = w, wn = w, wpn = w;
    int m = gw;
    if (m < M && act) { w = *(const v4u*)(Z + (size_t)m * NZP + 6144 + c); if ((m & (SEQ - 1)) != 0) wp = *(const v4u*)(Z + (size_t)(m - 1) * NZP + 6144 + c); }
    for (; m < M; m += NGW) {
        const int mn = m + NGW;
        wn = (v4u){0u, 0u, 0u, 0u}; wpn = wn;
        if (mn < M && act) { wn = *(const v4u*)(Z + (size_t)mn * NZP + 6144 + c); if ((mn & (SEQ - 1)) != 0) wpn = *(const v4u*)(Z + (size_t)(mn - 1) * NZP + 6144 + c); }
        v4u o = (v4u){0u, 0u, 0u, 0u};
        if (act) {
            float v[8] = {blo(w.x), bhi(w.x), blo(w.y), bhi(w.y), blo(w.z), bhi(w.z), blo(w.w), bhi(w.w)};
            const float vp[8] = {blo(wp.x), bhi(wp.x), blo(wp.y), bhi(wp.y), blo(wp.z), bhi(wp.z), blo(wp.w), bhi(wp.w)};
#pragma unroll
            for (int j = 0; j < 8; ++j) { float z = v[j] + mx[j] * (vp[j] - v[j]);
                if (c < 96) z = 1.0f - 2.0f / (1.0f + __expf(2.0f * z)); else if (c >= 192) z = 1.0f / (1.0f + __expf(-z));
                v[j] = z; }
            o.x = pk2(v[0], v[1]); o.y = pk2(v[2], v[3]); o.z = pk2(v[4], v[5]); o.w = pk2(v[6], v[7]); }
        *(v4u*)(AL + (size_t)m * LORAK + lane * 8) = o;
        w = wn; wp = wpn;
    }
    __syncthreads();
    quantize_cols32_wg(F, F.in[22], DFF, F.in[21], (signed char*)(ws + WS_W8M), (float*)(ws + WS_SWM), DFF / 32, 1 << 30, 0, 1 << 30, F.vcu, F.G);
    quantize_matrix(F, F.in[20], D, D, (signed char*)(ws + WS_W8O), nullptr, (const unsigned*)(ws + CTL_CMAXO), (float*)(ws + WS_SWO), 1 << 30, 0, 1 << 30);
}

__device__ __forceinline__ float t5_bias_bucket(int dist) {
    if (dist < 16) return (float)dist;
    int l = 16 + (int)(logf((float)dist / 16.0f) / 4.852030263919617f * 16.0f); return (float)(l < 31 ? l : 31);
}
constexpr int KL_STRIDE = 272, VT_STRIDE = 520, KL_BYTES = 256 * KL_STRIDE, VT_BYTES = 128 * VT_STRIDE, BT_OFF = KL_BYTES + VT_BYTES;
__device__ __forceinline__ void t_attn(Frame& F) {
    typedef short bf16x8 __attribute__((ext_vector_type(8)));
    unsigned char* ws = F.ws;
    const bf16* QKV = (const bf16*)(ws + WS_QKV); bf16* OG = (bf16*)(ws + WS_OG); float* LSE = (float*)(ws + WS_LSE); const float* relb = F.in[6];
    LAS unsigned char* KL = F.lds + RING_OFF; LAS unsigned char* VT = KL + KL_BYTES; LAS float* btab = (LAS float*)(KL + BT_OFF);
    for (int i = F.tid; i < 12 * 132; i += 512) { const int hh = i / 132, j = i % 132, gi = hh >> 2; float bb = 0.f;
        if (j <= 128) { const int bk = (int)t5_bias_bucket(j << (2 * gi)); bb = relb[bk * 12 + hh]; }
        btab[i] = bb; }
    const int tid = F.tid, lane = F.lane, w = F.wave, n = lane & 15, g = lane >> 4;
    const float SC = 0.08838834764831845f;
    const float* qgp = F.in[4];
    float kgn[8];
#pragma unroll
    for (int j = 0; j < 8; ++j) kgn[j] = F.in[5][8 * (tid & 15) + j];
    v4u kreg[8], vreg0[4], vreg1[4], qreg[4];
#define ATTN_LOAD(unit_) do { const int b_ = (unit_) / 384, rem_ = (unit_) % 384, h_ = rem_ >> 5, x_ = rem_ & 31, dl_ = 2 * (h_ >> 2), d_ = 1 << dl_, nbc_ = 32 >> dl_, r_ = x_ / nbc_, nb_ = x_ % nbc_; const size_t rowb_ = (size_t)b_ * SEQ; \
        _Pragma("unroll") for (int q_ = 0; q_ < 8; ++q_) { const int idx_ = tid + 512 * q_, key_ = idx_ >> 4, dch_ = idx_ & 15, ci_ = (nb_ - 1) * 128 + key_; kreg[q_] = (v4u){0u, 0u, 0u, 0u}; \
            if (ci_ >= 0) kreg[q_] = *(const v4u*)(QKV + (rowb_ + (size_t)(ci_ * d_ + r_)) * NQKV + 1536 + h_ * 128 + 8 * dch_); } \
        _Pragma("unroll") for (int q_ = 0; q_ < 4; ++q_) { const int idx_ = tid + 512 * q_, kp_ = idx_ >> 4, dch_ = idx_ & 15, ci_ = (nb_ - 1) * 128 + 2 * kp_; vreg0[q_] = (v4u){0u, 0u, 0u, 0u}; vreg1[q_] = vreg0[q_]; \
            if (ci_ >= 0) { const bf16* vp_ = QKV + (rowb_ + (size_t)(ci_ * d_ + r_)) * NQKV + 3072 + h_ * 128 + 8 * dch_; vreg0[q_] = *(const v4u*)vp_; vreg1[q_] = *(const v4u*)(vp_ + (size_t)d_ * NQKV); } } \
        { const size_t rowq_ = rowb_ + (size_t)((nb_ * 128 + 16 * w + n) * d_ + r_); \
        _Pragma("unroll") for (int ks_ = 0; ks_ < 4; ++ks_) qreg[ks_] = *(const v4u*)(QKV + rowq_ * NQKV + h_ * 128 + 32 * ks_ + 8 * g); } } while (0)
    if ((int)blockIdx.x < 1536) ATTN_LOAD((int)blockIdx.x);
    for (int unit = blockIdx.x; unit < 1536; unit += F.G) {
        const int b = unit / 384, rem = unit % 384, h = rem >> 5, x = rem & 31, gi = h >> 2, dl = 2 * gi, d = 1 << dl, nbc = 32 >> dl, r = x / nbc, nb = x % nbc;
        const size_t rowb = (size_t)b * SEQ;
        WG_BAR_LDS();
#pragma unroll
        for (int q = 0; q < 8; ++q) { const int idx = tid + 512 * q, key = idx >> 4, dch = idx & 15; const v4u val = kreg[q];
            float kv[8] = {blo(val.x), bhi(val.x), blo(val.y), bhi(val.y), blo(val.z), bhi(val.z), blo(val.w), bhi(val.w)}; float ss = 0.f;
#pragma unroll
            for (int j = 0; j < 8; ++j) ss += kv[j] * kv[j];
            ss += dppf<0xB1>(ss); ss += dppf<0x4E>(ss); ss += dppf<0x141>(ss); ss += dppf<0x140>(ss);
            const float rs = __builtin_amdgcn_rsqf(ss * (1.0f / 128.0f) + 1e-6f);
            v4u o; o.x = pk2(kv[0] * rs * kgn[0], kv[1] * rs * kgn[1]); o.y = pk2(kv[2] * rs * kgn[2], kv[3] * rs * kgn[3]); o.z = pk2(kv[4] * rs * kgn[4], kv[5] * rs * kgn[5]); o.w = pk2(kv[6] * rs * kgn[6], kv[7] * rs * kgn[7]);
            *(LAS v4u*)(KL + key * KL_STRIDE + dch * 16) = o; }
#pragma unroll
        for (int q = 0; q < 4; ++q) { const int idx = tid + 512 * q, kp = idx >> 4, dch = idx & 15; const v4u v0 = vreg0[q], v1 = vreg1[q];
            LAS unsigned char* o = VT + (8 * dch) * VT_STRIDE + 4 * kp;
            *(LAS unsigned*)(o + 0 * VT_STRIDE) = (v0.x & 0xffffu) | (v1.x << 16); *(LAS unsigned*)(o + 1 * VT_STRIDE) = (v0.x >> 16) | (v1.x & 0xffff0000u);
            *(LAS unsigned*)(o + 2 * VT_STRIDE) = (v0.y & 0xffffu) | (v1.y << 16); *(LAS unsigned*)(o + 3 * VT_STRIDE) = (v0.y >> 16) | (v1.y & 0xffff0000u);
            *(LAS unsigned*)(o + 4 * VT_STRIDE) = (v0.z & 0xffffu) | (v1.z << 16); *(LAS unsigned*)(o + 5 * VT_STRIDE) = (v0.z >> 16) | (v1.z & 0xffff0000u);
            *(LAS unsigned*)(o + 6 * VT_STRIDE) = (v0.w & 0xffffu) | (v1.w << 16); *(LAS unsigned*)(o + 7 * VT_STRIDE) = (v0.w >> 16) | (v1.w & 0xffff0000u); }
        const int qi = 16 * w + n; const size_t rowq = rowb + (size_t)((nb * 128 + qi) * d + r);
        bf16x8 qf[4];
        { v4u qr[4]; float qs = 0.f;
#pragma unroll
            for (int ks = 0; ks < 4; ++ks) { qr[ks] = qreg[ks];
                const float a0 = blo(qr[ks].x), a1 = bhi(qr[ks].x), a2 = blo(qr[ks].y), a3 = bhi(qr[ks].y), a4 = blo(qr[ks].z), a5 = bhi(qr[ks].z), a6 = blo(qr[ks].w), a7 = bhi(qr[ks].w);
                qs += (a0 * a0 + a1 * a1) + (a2 * a2 + a3 * a3) + (a4 * a4 + a5 * a5) + (a6 * a6 + a7 * a7); }
            qs += __shfl_xor(qs, 16); qs += __shfl_xor(qs, 32);
            const float rs = __builtin_amdgcn_rsqf(qs * (1.0f / 128.0f) + 1e-6f) * SC;
#pragma unroll
            for (int ks = 0; ks < 4; ++ks) { const f32x4 g0 = *(const f32x4*)(qgp + 32 * ks + 8 * g), g1 = *(const f32x4*)(qgp + 32 * ks + 8 * g + 4); u32x4_t w;
                w.x = pk2(blo(qr[ks].x) * rs * g0.x, bhi(qr[ks].x) * rs * g0.y); w.y = pk2(blo(qr[ks].y) * rs * g0.z, bhi(qr[ks].y) * rs * g0.w);
                w.z = pk2(blo(qr[ks].z) * rs * g1.x, bhi(qr[ks].z) * rs * g1.y); w.w = pk2(blo(qr[ks].w) * rs * g1.z, bhi(qr[ks].w) * rs * g1.w);
                qf[ks] = __builtin_bit_cast(bf16x8, w); } }
        if (unit + (int)F.G < 1536) ATTN_LOAD(unit + (int)F.G);
        WG_BAR_LDS();
        f32x4 sacc[9];
#pragma unroll
        for (int u = 0; u < 9; ++u) { f32x4 acc = (f32x4){0.f, 0.f, 0.f, 0.f};
#pragma unroll
            for (int ks = 0; ks < 4; ++ks) { const bf16x8 a = *(const LAS bf16x8*)(KL + (16 * (w + u) + n) * KL_STRIDE + (32 * ks + 8 * g) * 2); acc = __builtin_amdgcn_mfma_f32_16x16x32_bf16(a, qf[ks], acc, 0, 0, 0); }
            sacc[u] = acc; }
        const LAS float* bt = btab + h * 132; float mx = -1e30f;
#pragma unroll
        for (int u = 0; u < 9; ++u)
#pragma unroll
            for (int i = 0; i < 4; ++i) { const int rel = 128 + n - 16 * u - 4 * g - i, kj = 16 * (w + u) + 4 * g + i; const bool ok = rel >= 0 && rel <= 128 && (nb > 0 || kj >= 128);
                const float sv = ok ? sacc[u][i] + bt[rel < 0 ? 0 : (rel > 128 ? 128 : rel)] : -1e30f; sacc[u][i] = sv; mx = fmaxf(mx, sv); }
        mx = fmaxf(mx, __shfl_xor(mx, 16)); mx = fmaxf(mx, __shfl_xor(mx, 32));
        float l = 0.f;
#pragma unroll
        for (int u = 0; u < 9; ++u)
#pragma unroll
            for (int i = 0; i < 4; ++i) { const float p = __expf(sacc[u][i] - mx); sacc[u][i] = p; l += p; }
        l += __shfl_xor(l, 16); l += __shfl_xor(l, 32);
        f32x4 oacc[8];
#pragma unroll
        for (int dt = 0; dt < 8; ++dt) oacc[dt] = (f32x4){0.f, 0.f, 0.f, 0.f};
#pragma unroll
        for (int blk = 0; blk < 5; ++blk) { const int u0 = 2 * blk, u1 = (2 * blk + 1 < 9) ? 2 * blk + 1 : u0;
            u32x4_t pw; pw.x = pg8::cvt_pk_bf16(sacc[u0][0], sacc[u0][1]); pw.y = pg8::cvt_pk_bf16(sacc[u0][2], sacc[u0][3]);
            if (2 * blk + 1 < 9) { pw.z = pg8::cvt_pk_bf16(sacc[u1][0], sacc[u1][1]); pw.w = pg8::cvt_pk_bf16(sacc[u1][2], sacc[u1][3]); } else { pw.z = 0u; pw.w = 0u; }
            const bf16x8 pf = __builtin_bit_cast(bf16x8, pw);
#pragma unroll
            for (int dt = 0; dt < 8; ++dt) { const LAS unsigned char* vr = VT + (16 * dt + n) * VT_STRIDE + 8 * g;
                const v2u lo = *(const LAS v2u*)(vr + 32 * (w + u0)), hi = *(const LAS v2u*)(vr + 32 * (w + u1));
                u32x4_t aw; aw.x = lo.x; aw.y = lo.y; aw.z = hi.x; aw.w = hi.y;
                oacc[dt] = __builtin_amdgcn_mfma_f32_16x16x32_bf16(__builtin_bit_cast(bf16x8, aw), pf, oacc[dt], 0, 0, 0); } }
        const float inv = 1.0f / l; bf16* op = OG + rowq * 1536 + h * 128 + 4 * g;
#pragma unroll
        for (int dt = 0; dt < 8; ++dt) { v2u o; o.x = pk2(oacc[dt][0] * inv, oacc[dt][1] * inv); o.y = pk2(oacc[dt][2] * inv, oacc[dt][3] * inv); *(v2u*)(op + 16 * dt) = o; }
        if (g == 0) LSE[rowq * 12 + h] = mx + __logf(l);
    }
}
__device__ __forceinline__ void attn_merge(Frame& F) {
    unsigned char* ws = F.ws;
    const bf16* OG = (const bf16*)(ws + WS_OG); const float* LSE = (const float*)(ws + WS_LSE); bf16* ATT = (bf16*)(ws + WS_ATT);
    const int gw = F.vcu * NWAVES + F.wave, NGW = F.G * NWAVES, lane = F.lane;
    for (int it = gw; it < M * 4; it += NGW) { const int m = it >> 2, hg = it & 3;
        const float l0 = LSE[(size_t)m * 12 + hg], l1 = LSE[(size_t)m * 12 + 4 + hg], l2 = LSE[(size_t)m * 12 + 8 + hg], mx = fmaxf(l0, fmaxf(l1, l2));
        const float e0 = __expf(l0 - mx), e1 = __expf(l1 - mx), e2 = __expf(l2 - mx), inv = 1.0f / (e0 + e1 + e2);
        const bf16* op = OG + (size_t)m * 1536 + hg * 128 + 2 * lane;
        const unsigned a = *(const unsigned*)op, bq = *(const unsigned*)(op + 512), c = *(const unsigned*)(op + 1024);
        *(unsigned*)(ATT + (size_t)m * AOW + hg * 128 + 2 * lane) = pk2((e0 * blo(a) + e1 * blo(bq) + e2 * blo(c)) * inv, (e0 * bhi(a) + e1 * bhi(bq) + e2 * bhi(c)) * inv); }
}

constexpr int NCH = 8, CHL = SEQ / NCH, TBK = 8, STEPF = 384;
struct ScanRaw { float r[5], k[5], v[5], e[4], a[4]; };
__device__ __forceinline__ void scan_load_raw(ScanRaw& R, const bf16* Z, const bf16* EAG, size_t row0, int t0, int c) {
#pragma unroll
    for (int i = 0; i < 5; ++i) { const bool ok = (i > 0) || (t0 > 0); const bf16* zr = Z + (row0 + i - 1) * NZP;
        R.r[i] = ok ? bf1(zr[c]) : 0.f; R.k[i] = ok ? bf1(zr[2048 + c]) : 0.f; R.v[i] = ok ? bf1(zr[4096 + c]) : 0.f; }
#pragma unroll
    for (int i = 0; i < 4; ++i) { R.e[i] = bf1(EAG[(row0 + i) * 2048 + c]); R.a[i] = bf1(EAG[(size_t)M * 2048 + (row0 + i) * 2048 + c]); }
}
__device__ __forceinline__ void scan_prep4(const ScanRaw& R, LAS float* rec  , float* rkb  , int lane,
                                           float mr, float mk, float mv, float kkc, float kac, float rkc) {
#pragma unroll
    for (int i = 0; i < 4; ++i) {
        const float r = R.r[i + 1] + mr * (R.r[i] - R.r[i + 1]), k = R.k[i + 1] + mk * (R.k[i] - R.k[i + 1]), v = R.v[i + 1] + mv * (R.v[i] - R.v[i + 1]);
        const float decay = __expf(-R.e[i]), a = R.a[i];
        const float kkj = k * kkc, n2 = wave_sum_dpp(kkj * kkj), kk = kkj * __builtin_amdgcn_rsqf(fmaxf(n2, 1e-24f));
        const float kp = k * (1.0f + (a - 1.0f) * kac);
        const float rks = wave_sum_dpp(r * kp * rkc);
        LAS float* o = rec + i * STEPF + lane;
        o[0] = -kk; o[64] = decay; o[128] = kk * a; o[192] = kp; o[256] = r; o[320] = v;
        if (lane == 0) rkb[i * 32] = rks;
    }
}
typedef float f2 __attribute__((ext_vector_type(2)));
struct St { f2 v[8][4]; };
template <bool IS_S> __device__ __forceinline__ void scan_step(St& S, const LAS float* rec, int rg, int cg, float* yout, bool writer) {
    const LAS f32x4* p = (const LAS f32x4*)rec + cg * 2;
    const f32x4 a0 = p[0], a1 = p[1], w0 = p[16], w1 = p[17], b0 = p[32], b1 = p[33], r0 = p[64], r1 = p[65];
    const f2 a[4] = {a0.xy, a0.zw, a1.xy, a1.zw}, w[4] = {w0.xy, w0.zw, w1.xy, w1.zw}, b[4] = {b0.xy, b0.zw, b1.xy, b1.zw}, rr[4] = {r0.xy, r0.zw, r1.xy, r1.zw};
    float sa[8];
#pragma unroll
    for (int r = 0; r < 8; ++r) { f2 s = S.v[r][0] * a[0]; s = S.v[r][1] * a[1] + s; s = S.v[r][2] * a[2] + s; s = S.v[r][3] * a[3] + s; sa[r] = s.x + s.y; }
#pragma unroll
    for (int r = 0; r < 8; ++r) sa[r] = red8(sa[r]);
    if (IS_S) {
        const f32x4 k0 = p[48], k1 = p[49]; const LAS f32x4* pv = (const LAS f32x4*)rec + 80 + rg * 2; const f32x4 v0 = pv[0], v1 = pv[1];
        const f2 k[4] = {k0.xy, k0.zw, k1.xy, k1.zw}; const float v[8] = {v0.x, v0.y, v0.z, v0.w, v1.x, v1.y, v1.z, v1.w};
#pragma unroll
        for (int r = 0; r < 8; ++r) { const f2 sr = (f2){sa[r], sa[r]}, vr = (f2){v[r], v[r]};
#pragma unroll
            for (int q = 0; q < 4; ++q) { f2 t = S.v[r][q] * w[q]; t = sr * b[q] + t; S.v[r][q] = vr * k[q] + t; } }
    } else {
#pragma unroll
        for (int r = 0; r < 8; ++r) { const f2 sr = (f2){sa[r], sa[r]};
#pragma unroll
            for (int q = 0; q < 4; ++q) { const f2 t = S.v[r][q] * w[q]; S.v[r][q] = sr * b[q] + t; } }
    }
    float y[8];
#pragma unroll
    for (int r = 0; r < 8; ++r) { f2 s = S.v[r][0] * rr[0]; s = S.v[r][1] * rr[1] + s; s = S.v[r][2] * rr[2] + s; s = S.v[r][3] * rr[3] + s; y[r] = s.x + s.y; }
#pragma unroll
    for (int r = 0; r < 8; ++r) y[r] = red8(y[r]);
    if (writer) { if (IS_S) { f32x4* yo = (f32x4*)yout; yo[0] = (f32x4){y[0], y[1], y[2], y[3]}; yo[1] = (f32x4){y[4], y[5], y[6], y[7]}; }
                  else { v4u o; o.x = pk2(y[0], y[1]); o.y = pk2(y[2], y[3]); o.z = pk2(y[4], y[5]); o.w = pk2(y[6], y[7]); *(v4u*)yout = o; } }
}
constexpr int SC_RM = 144;
constexpr int SC_TR = 40;
constexpr int SC_AT = 0, SC_RT = 2304, SC_BT = 4608, SC_KT = 6912, SC_W = 9216, SC_ATT = 11520, SC_BHT = 14080, SC_KHT = 16640, SC_VT = 19200, SC_GC = 21760, SC_L = 22016, SC_T = 23040,
              SC_AAK = 23552, SC_ARB = 24064, SC_ARK = 24576, SC_RAW = 25088, SC_WAVE = 35328;
typedef short bf16x8s __attribute__((ext_vector_type(8)));
__device__ __forceinline__ bf16x8s mk8(v2u lo, v2u hi) { u32x4_t w; w.x = lo.x; w.y = lo.y; w.z = hi.x; w.w = hi.y; return __builtin_bit_cast(bf16x8s, w); }
__device__ __forceinline__ v2u pk4(const f32x4 v) { v2u w; w.x = pg8::cvt_pk_bf16_n(v.x, v.y); w.y = pg8::cvt_pk_bf16_n(v.z, v.w); return w; }
#define SC_MFMA(a, b, c) __builtin_amdgcn_mfma_f32_16x16x32_bf16((a), (b), (c), 0, 0, 0)
#define SC_BAR() do { asm volatile("s_waitcnt lgkmcnt(0)" ::: "memory"); __builtin_amdgcn_s_barrier(); asm volatile("" ::: "memory"); } while (0)
__device__ __forceinline__ void t_scan1(Frame& F) {
    unsigned char* ws = F.ws;
    const bf16* Z = (const bf16*)(ws + WS_Z); const bf16* EAG = (const bf16*)(ws + WS_EAG);
    bf16* YLOC = (bf16*)(ws + WS_YLOC); bf16* GBUF = (bf16*)(ws + WS_GBUF); float* LST = (float*)(ws + WS_LST); float* TST = (float*)(ws + WS_TST); float* RKB = (float*)(ws + WS_RKB);
    const float* mix = F.in[8]; const float* k_k = F.in[14]; const float* k_a = F.in[15]; const float* r_k = F.in[16];
    const int lane = F.lane, wave = F.wave, pr = wave & 3, n = lane & 15, q = lane >> 4;
    const bool isT = wave >= 4;
    LAS unsigned char* WB = F.lds + RING_OFF + pr * SC_WAVE;
    const v2u z2 = (v2u){0u, 0u};
    for (int wi = blockIdx.x; wi < 128 * NCH / 4; wi += F.G) {
        const int pair = wi * 4 + pr, unit = pair / NCH, ch = pair % NCH, b = unit >> 5, h = unit & 31, c = h * 64 + lane;
        const size_t rowc = (size_t)b * SEQ + (size_t)ch * CHL;
        const int tc = ch * CHL;
        const bool phi_on = ch > 0;
        f32x4 acc[4][4];
#pragma unroll
        for (int jt = 0; jt < 4; ++jt)
#pragma unroll
            for (int it = 0; it < 4; ++it)
#pragma unroll
                for (int r = 0; r < 4; ++r) acc[jt][it][r] = (isT && jt == it && 4 * q + r == n) ? 1.f : 0.f;
        const float mr = mix[c], mk = mix[2048 + c], mv = mix[4096 + c], kkc = k_k[c], kac = k_a[c], rkc = r_k[c];
        v4u raw[5];
        const int hf = isT ? 1 : 0;
        const unsigned lo_z = (unsigned)(lane >> 3) * (NZP * 2) + (unsigned)(lane & 7) * 16, lo_e = (unsigned)(lane >> 3) * 4096 + (unsigned)(lane & 7) * 16, lo_l = (unsigned)(lane >> 3) * 640 + (unsigned)(lane & 7) * 16;
        { const char* zb = (const char*)(Z + (rowc + 8 * hf) * NZP + h * 64); const char* eb = (const char*)(EAG + (rowc + 8 * hf) * 2048 + h * 64);
#pragma unroll
            for (int i = 0; i < 5; ++i) raw[i] = i < 3 ? *(const v4u*)(zb + i * 4096 + lo_z) : *(const v4u*)(eb + (size_t)(i - 3) * M * 4096 + lo_e); }
        bf16 pz0 = 0, pz1 = 0, pz2 = 0;
        if (!isT && tc > 0) { const bf16* zp = Z + (rowc - 1) * NZP; pz0 = zp[c]; pz1 = zp[2048 + c]; pz2 = zp[4096 + c]; }
#pragma unroll 1
        for (int sc = 0; sc < CHL / 16; ++sc) {
            const size_t rows = rowc + (size_t)sc * 16;
            {
#pragma unroll
                for (int i = 0; i < 5; ++i) *(LAS v4u*)(WB + SC_RAW + hf * 8 * 640 + i * 128 + lo_l) = raw[i];
                float pzr = bf1(pz0), pzk = bf1(pz1), pzv = bf1(pz2);
                if (sc + 1 < CHL / 16) { const char* zb = (const char*)(Z + (rows + 16 + 8 * hf) * NZP + h * 64); const char* eb = (const char*)(EAG + (rows + 16 + 8 * hf) * 2048 + h * 64);
#pragma unroll
                    for (int i = 0; i < 5; ++i) raw[i] = i < 3 ? *(const v4u*)(zb + i * 4096 + lo_z) : *(const v4u*)(eb + (size_t)(i - 3) * M * 4096 + lo_e);
                    if (!isT) { const bf16* zp = Z + (rows + 15) * NZP; pz0 = zp[c]; pz1 = zp[2048 + c]; pz2 = zp[4096 + c]; } }
                SC_BAR();
                const LAS bf16* RAWL = (const LAS bf16*)(WB + SC_RAW);
                float E2C = 0.f, E2 = 0.f;
#pragma unroll
                for (int t = 0; t < 16; ++t) { const float e2 = bf1(RAWL[t * 320 + 192 + lane]) * 1.4426950408889634f; E2C += e2; if (t < 8) E2 += e2; }
                float gprev = 1.f;
                if (isT) { gprev = __builtin_amdgcn_exp2f(-E2); pzr = bf1(RAWL[7 * 320 + lane]); pzk = bf1(RAWL[7 * 320 + 64 + lane]); pzv = bf1(RAWL[7 * 320 + 128 + lane]); } else E2 = 0.f;
#pragma unroll 1
                for (int qh = 0; qh < 2; ++qh) {
                    const int qt = 2 * hf + qh;
                    unsigned ath[2], bhh[2], khh[2], vth[2];
#pragma unroll
                    for (int tq = 0; tq < 4; ++tq) { const int t = 4 * qt + tq;
                        const float zr = bf1(RAWL[t * 320 + lane]), zk = bf1(RAWL[t * 320 + 64 + lane]), zv = bf1(RAWL[t * 320 + 128 + lane]), e = bf1(RAWL[t * 320 + 192 + lane]), ag = bf1(RAWL[t * 320 + 256 + lane]);
                        const float r = zr + mr * (pzr - zr), k = zk + mk * (pzk - zk), v = zv + mv * (pzv - zv); pzr = zr; pzk = zk; pzv = zv;
                        const float kkj = k * kkc, n2 = wave_sum_dpp(kkj * kkj), kk = kkj * __builtin_amdgcn_rsqf(fmaxf(n2, 1e-24f));
                        const float kp = k * (1.0f + (ag - 1.0f) * kac), bb = kk * ag;
                        const float rks = wave_sum_dpp(r * kp * rkc);
                        if (lane == 0) RKB[(rows + t) * 32 + h] = rks;
                        E2 += e * 1.4426950408889634f;
                        const float gm = __builtin_amdgcn_exp2f(-E2), gi = __builtin_amdgcn_exp2f(E2), gh = __builtin_amdgcn_exp2f(E2 - E2C);
                        const float at = -kk * gprev, rt = r * gm, bt = bb * gi, kt = kp * gi, bh = bb * gh, kh = kp * gh; gprev = gm;
                        LAS bf16* o = (LAS bf16*)(WB + t * SC_RM) + lane;
                        o[SC_AT / 2] = (bf16)f2bf(at); o[SC_RT / 2] = (bf16)f2bf(rt); o[SC_BT / 2] = (bf16)f2bf(bt); o[SC_KT / 2] = (bf16)f2bf(kt);
                        if (tq & 1) { ath[tq >> 1] |= f2bf(at) << 16; bhh[tq >> 1] |= f2bf(bh) << 16; khh[tq >> 1] |= f2bf(kh) << 16; vth[tq >> 1] |= f2bf(v) << 16; }
                        else { ath[tq >> 1] = f2bf(at); bhh[tq >> 1] = f2bf(bh); khh[tq >> 1] = f2bf(kh); vth[tq >> 1] = f2bf(v); }
                    }
                    *(LAS v2u*)(WB + SC_ATT + lane * SC_TR + qt * 8) = (v2u){ath[0], ath[1]}; *(LAS v2u*)(WB + SC_BHT + lane * SC_TR + qt * 8) = (v2u){bhh[0], bhh[1]};
                    *(LAS v2u*)(WB + SC_KHT + lane * SC_TR + qt * 8) = (v2u){khh[0], khh[1]}; *(LAS v2u*)(WB + SC_VT + lane * SC_TR + qt * 8) = (v2u){vth[0], vth[1]};
                }
                if (!isT) ((LAS float*)(WB + SC_GC))[lane] = __builtin_amdgcn_exp2f(-E2C);
            }
            SC_BAR();
            if (!isT) {
                f32x4 mab = (f32x4){0.f, 0.f, 0.f, 0.f}, mak = mab, mrb = mab, mrk = mab;
#pragma unroll
                for (int ks = 0; ks < 2; ++ks) { const int co = (32 * ks + 8 * q) * 2;
                    const bf16x8s fa = *(const LAS bf16x8s*)(WB + SC_AT + n * SC_RM + co), fr = *(const LAS bf16x8s*)(WB + SC_RT + n * SC_RM + co);
                    const bf16x8s fb = *(const LAS bf16x8s*)(WB + SC_BT + n * SC_RM + co), fk = *(const LAS bf16x8s*)(WB + SC_KT + n * SC_RM + co);
                    mab = SC_MFMA(fa, fb, mab); mak = SC_MFMA(fa, fk, mak); mrb = SC_MFMA(fr, fb, mrb); mrk = SC_MFMA(fr, fk, mrk); }
#pragma unroll
                for (int r = 0; r < 4; ++r) { const int t = 4 * q + r; const bool lo = n < t, le = n <= t;
                    ((LAS float*)(WB + SC_L))[t * 16 + n] = lo ? mab[r] : 0.f;
                    ((LAS bf16*)(WB + SC_AAK))[t * 16 + n] = (bf16)f2bf(lo ? mak[r] : 0.f);
                    ((LAS bf16*)(WB + SC_ARB))[t * 16 + n] = (bf16)f2bf(le ? mrb[r] : 0.f);
                    ((LAS bf16*)(WB + SC_ARK))[t * 16 + n] = (bf16)f2bf(le ? mrk[r] : 0.f); }
                { float x[16];
#pragma unroll
                    for (int t = 0; t < 16; ++t) x[t] = 0.f;
#pragma unroll
                    for (int t = 0; t < 16; ++t) { float a_ = (t == n) ? 1.f : 0.f;
#pragma unroll
                        for (int s4 = 0; s4 < (t + 3) / 4; ++s4) { const f32x4 l = *(const LAS f32x4*)(WB + SC_L + t * 64 + s4 * 16); a_ += l.x * x[4 * s4] + l.y * x[4 * s4 + 1] + l.z * x[4 * s4 + 2] + l.w * x[4 * s4 + 3]; }
                        x[t] = a_; }
                    if (q == 0) {
#pragma unroll
                        for (int t = 0; t < 16; ++t) ((LAS bf16*)(WB + SC_T))[t * 16 + n] = (bf16)f2bf(x[t]); } }
                { const bf16x8s tf = mk8(*(const LAS v2u*)(WB + SC_T + n * 32 + 8 * q), z2);
#pragma unroll
                    for (int jt = 0; jt < 4; ++jt) { const bf16x8s bfm = mk8(*(const LAS v2u*)(WB + SC_ATT + (16 * jt + n) * SC_TR + 8 * q), z2);
                        const f32x4 w = SC_MFMA(tf, bfm, ((f32x4){0.f, 0.f, 0.f, 0.f}));
#pragma unroll
                        for (int r = 0; r < 4; ++r) ((LAS bf16*)(WB + SC_W + (4 * q + r) * SC_RM))[16 * jt + n] = (bf16)f2bf(w[r]); } }
            }
            SC_BAR();
            if (!isT || phi_on) {
                int nn = n, qq = q; asm volatile("" : "+v"(nn), "+v"(qq));
                bf16x8s wf[2], rf[2];
#pragma unroll
                for (int s = 0; s < 2; ++s) { wf[s] = mk8(*(const LAS v2u*)(WB + SC_W + n * SC_RM + (32 * s + 4 * q) * 2), *(const LAS v2u*)(WB + SC_W + n * SC_RM + (32 * s + 16 + 4 * q) * 2));
                    rf[s] = mk8(*(const LAS v2u*)(WB + SC_RT + n * SC_RM + (32 * s + 4 * q) * 2), *(const LAS v2u*)(WB + SC_RT + n * SC_RM + (32 * s + 16 + 4 * q) * 2)); }
                const bf16x8s abf = mk8(*(const LAS v2u*)(WB + SC_ARB + n * 32 + 8 * q), isT ? z2 : *(const LAS v2u*)(WB + SC_ARK + n * 32 + 8 * q));
                const bf16x8s tf = mk8(*(const LAS v2u*)(WB + SC_T + n * 32 + 8 * q), z2), akf = mk8(*(const LAS v2u*)(WB + SC_AAK + n * 32 + 8 * q), z2);
                f32x4 gc[4];
#pragma unroll
                for (int jt = 0; jt < 4; ++jt) gc[jt] = *(const LAS f32x4*)(WB + SC_GC + (16 * jt + 4 * q) * 4);
#pragma unroll
                for (int it = 0; it < 4; ++it) {
                    const v2u vt = isT ? z2 : *(const LAS v2u*)(WB + SC_VT + (16 * it + n) * SC_TR + 8 * q);
                    f32x4 u = (f32x4){0.f, 0.f, 0.f, 0.f};
                    if (!isT) { const f32x4 zz = SC_MFMA(akf, mk8(vt, z2), ((f32x4){0.f, 0.f, 0.f, 0.f})); u = SC_MFMA(tf, mk8(pk4(zz), z2), u); }
                    const bf16x8s sf0 = mk8(pk4(acc[0][it]), pk4(acc[1][it])), sf1 = mk8(pk4(acc[2][it]), pk4(acc[3][it]));
                    u = SC_MFMA(wf[0], sf0, u); u = SC_MFMA(wf[1], sf1, u);
                    f32x4 y = SC_MFMA(rf[0], sf0, ((f32x4){0.f, 0.f, 0.f, 0.f})); y = SC_MFMA(rf[1], sf1, y);
                    const bf16x8s uv = mk8(pk4(u), vt);
                    y = SC_MFMA(abf, uv, y);
                    if (isT) { bf16* go = GBUF + (rows + 4 * qq) * 2048 + h * 64 + 16 * it + nn;
#pragma unroll
                        for (int r = 0; r < 4; ++r) go[(size_t)r * 2048] = (bf16)f2bf(y[r]); }
                    else { bf16* yo = YLOC + (rows + 4 * qq) * 2048 + h * 64 + 16 * it + nn;
#pragma unroll
                        for (int r = 0; r < 4; ++r) yo[(size_t)r * 2048] = (bf16)f2bf(y[r]); }
#pragma unroll
                    for (int jt = 0; jt < 4; ++jt) { const bf16x8s bk = mk8(*(const LAS v2u*)(WB + SC_BHT + (16 * jt + n) * SC_TR + 8 * q), isT ? z2 : *(const LAS v2u*)(WB + SC_KHT + (16 * jt + n) * SC_TR + 8 * q));
                        acc[jt][it] = SC_MFMA(bk, uv, acc[jt][it] * gc[jt]); }
                }
            }
            SC_BAR();
        }
        if (!isT || phi_on) { int nn = n, qq = q; asm volatile("" : "+v"(nn), "+v"(qq)); float* st = (isT ? TST : LST) + ((size_t)unit * NCH + ch) * 4096;
#pragma unroll
            for (int jt = 0; jt < 4; ++jt)
#pragma unroll
                for (int it = 0; it < 4; ++it) *(f32x4*)(st + (16 * it + nn) * 64 + 16 * jt + 4 * qq) = acc[jt][it]; }
    }
}
__device__ __forceinline__ void t_carry(Frame& F) {
    unsigned char* ws = F.ws;
    float* LST = (float*)(ws + WS_LST); const float* TST = (const float*)(ws + WS_TST);
    LAS float* SL = (LAS float*)(F.lds + RING_OFF);
    LAS float* TL = SL + 4096;
    const int tid = F.tid, i = tid >> 3, jg = tid & 7;
    for (int unit = blockIdx.x; unit < 128; unit += F.G) {
        const float* ub = LST + (size_t)unit * NCH * 4096; const float* tb = TST + (size_t)unit * NCH * 4096;
        __syncthreads();
        for (int q = tid; q < 1024; q += 512) ((LAS f32x4*)SL)[q] = ((const f32x4*)ub)[q];
        for (int q = tid; q < 1024 * (NCH - 2); q += 512) ((LAS f32x4*)TL)[q] = ((const f32x4*)(tb + 4096))[q];
        f32x4 l0[NCH - 2], l1[NCH - 2];
#pragma unroll
        for (int c = 1; c < NCH - 1; ++c) { l0[c - 1] = ((const f32x4*)(ub + (size_t)c * 4096 + i * 64 + 8 * jg))[0]; l1[c - 1] = ((const f32x4*)(ub + (size_t)c * 4096 + i * 64 + 8 * jg))[1]; }
        __syncthreads();
#pragma unroll
        for (int c = 1; c < NCH - 1; ++c) {
            f32x4 o0 = l0[c - 1], o1 = l1[c - 1]; const LAS float* tl = TL + (c - 1) * 4096;
#pragma unroll 8
            for (int j = 0; j < 64; ++j) { const float s = SL[i * 64 + j]; const f32x4 t0 = *(const LAS f32x4*)(tl + j * 64 + 8 * jg), t1 = *(const LAS f32x4*)(tl + j * 64 + 8 * jg + 4); o0 += t0 * s; o1 += t1 * s; }
            float* l_g = LST + ((size_t)unit * NCH + c) * 4096;
            ((f32x4*)(l_g + i * 64 + 8 * jg))[0] = o0; ((f32x4*)(l_g + i * 64 + 8 * jg))[1] = o1;
            WG_BAR_LDS();
            *(LAS f32x4*)(SL + i * 64 + 8 * jg) = o0; *(LAS f32x4*)(SL + i * 64 + 8 * jg + 4) = o1;
            WG_BAR_LDS();
        }
    }
}
__device__ __forceinline__ void t_fix(Frame& F) {
    typedef short bf16x8 __attribute__((ext_vector_type(8)));
    unsigned char* ws = F.ws;
    const bf16* Z = (const bf16*)(ws + WS_Z); const bf16* EAG = (const bf16*)(ws + WS_EAG); bf16* RW = (bf16*)(ws + WS_RW);
    const bf16* YLOC = (const bf16*)(ws + WS_YLOC); const bf16* GBUF = (const bf16*)(ws + WS_GBUF); const float* LST = (const float*)(ws + WS_LST); const float* RKB = (const float*)(ws + WS_RKB);
    const float* mix = F.in[8]; const float* gn_w = F.in[17]; const float* gn_b = F.in[18];
    const int lane = F.lane, n = lane & 15, q = lane >> 4;
    const int gw = F.vcu * NWAVES + F.wave, NGW = F.G * NWAVES;
    for (int it = gw; it < 128 * (SEQ / 64); it += NGW) {
        const int unit = it / (SEQ / 64), tb = it % (SEQ / 64), ch = tb / (CHL / 64), b = unit >> 5, h = unit & 31;
        const size_t row0 = (size_t)b * SEQ + (size_t)tb * 64;
        bf16x8 Af[4][2];
        if (ch > 0) { const float* sg = LST + ((size_t)unit * NCH + (ch - 1)) * 4096;
#pragma unroll
            for (int mt = 0; mt < 4; ++mt)
#pragma unroll
                for (int ks = 0; ks < 2; ++ks) { const f32x4 s0 = *(const f32x4*)(sg + (16 * mt + n) * 64 + 32 * ks + 8 * q), s1 = *(const f32x4*)(sg + (16 * mt + n) * 64 + 32 * ks + 8 * q + 4);
                    u32x4_t w; w.x = pk2(s0.x, s0.y); w.y = pk2(s0.z, s0.w); w.z = pk2(s1.x, s1.y); w.w = pk2(s1.z, s1.w); Af[mt][ks] = __builtin_bit_cast(bf16x8, w); } }
        f32x4 gwv[4], gbv[4], mvv[4];
#pragma unroll
        for (int mt = 0; mt < 4; ++mt) { const int c = h * 64 + 16 * mt + 4 * q; gwv[mt] = *(const f32x4*)(gn_w + c); gbv[mt] = *(const f32x4*)(gn_b + c); mvv[mt] = *(const f32x4*)(mix + 4096 + c); }
#pragma unroll 1
        for (int nt = 0; nt < 4; ++nt) {
            const int t = 16 * nt + n, tt = tb * 64 + t; const size_t row = row0 + t;
            f32x4 y[4];
#pragma unroll
            for (int mt = 0; mt < 4; ++mt) { const v2u yw = *(const v2u*)(YLOC + row * 2048 + h * 64 + 16 * mt + 4 * q); y[mt] = (f32x4){blo(yw.x), bhi(yw.x), blo(yw.y), bhi(yw.y)}; }
            v2u vc[4], vp[4], gt[4];
#pragma unroll
            for (int mt = 0; mt < 4; ++mt) { const bf16* zr = Z + row * NZP + 4096 + h * 64 + 16 * mt + 4 * q; vc[mt] = *(const v2u*)zr; vp[mt] = tt > 0 ? *(const v2u*)(zr - NZP) : (v2u){0u, 0u};
                gt[mt] = *(const v2u*)(EAG + (size_t)2 * M * 2048 + row * 2048 + h * 64 + 16 * mt + 4 * q); }
            const float rk = RKB[row * 32 + h];
            if (ch > 0) { bf16x8 Bf[2];
#pragma unroll
                for (int ks = 0; ks < 2; ++ks) Bf[ks] = *(const bf16x8*)(GBUF + row * 2048 + h * 64 + 32 * ks + 8 * q);
#pragma unroll
                for (int mt = 0; mt < 4; ++mt) { f32x4 acc = (f32x4){0.f, 0.f, 0.f, 0.f};
#pragma unroll
                    for (int ks = 0; ks < 2; ++ks) acc = __builtin_amdgcn_mfma_f32_16x16x32_bf16(Af[mt][ks], Bf[ks], acc, 0, 0, 0);
                    y[mt] += acc; } }
            float s = 0.f;
#pragma unroll
            for (int mt = 0; mt < 4; ++mt) s += (y[mt].x + y[mt].y) + (y[mt].z + y[mt].w);
            s += __shfl_xor(s, 16); s += __shfl_xor(s, 32);
            const float mu = s * (1.0f / 64.0f); float vs = 0.f;
#pragma unroll
            for (int mt = 0; mt < 4; ++mt) { y[mt] = y[mt] - mu; vs += (y[mt].x * y[mt].x + y[mt].y * y[mt].y) + (y[mt].z * y[mt].z + y[mt].w * y[mt].w); }
            vs += __shfl_xor(vs, 16); vs += __shfl_xor(vs, 32);
            const float rstd = __builtin_amdgcn_rsqf(vs * (1.0f / 64.0f) + 64e-5f);
#pragma unroll
            for (int mt = 0; mt < 4; ++mt) {
                const f32x4 vcur = (f32x4){blo(vc[mt].x), bhi(vc[mt].x), blo(vc[mt].y), bhi(vc[mt].y)}, vprv = (f32x4){blo(vp[mt].x), bhi(vp[mt].x), blo(vp[mt].y), bhi(vp[mt].y)};
                const f32x4 v = vcur + mvv[mt] * (vprv - vcur), g = (f32x4){blo(gt[mt].x), bhi(gt[mt].x), blo(gt[mt].y), bhi(gt[mt].y)};
                const f32x4 o = (y[mt] * rstd * gwv[mt] + gbv[mt] + v * rk) * g;
                v2u w; w.x = pk2(o.x, o.y); w.y = pk2(o.z, o.w); *(v2u*)(RW + row * 2048 + h * 64 + 16 * mt + 4 * q) = w; }
        }
    }
}

struct Args { const float* in[27]; float* out; unsigned char* ws; int ph_lo, ph_hi; };
__global__ void __launch_bounds__(NWAVES * 64, 2) mk_fwd(Args args) {
    extern __shared__ __attribute__((aligned(16))) unsigned char lds[];
    Frame F;
    F.lds = (LAS unsigned char*)lds;
    F.MISC = (volatile LAS unsigned*)(F.lds + MISC_OFF);
    F.tid = threadIdx.x; F.lane = F.tid & 63; F.wave = __builtin_amdgcn_readfirstlane(F.tid >> 6);
    F.G = gridDim.x; { const int bx = blockIdx.x; F.vcu = (F.G % 8 == 0) ? (bx % 8) * (F.G / 8) + bx / 8 : bx; }
#pragma unroll
    for (int i = 0; i < 27; ++i) F.in[i] = args.in[i];
    F.out = args.out; F.ws = args.ws; unsigned char* ws = args.ws;
    F.ctl = (gu32*)(ws + WS_CTL);
    for (int u = F.tid; u < (LDS_BYTES - LDSCTL_OFF) / 4; u += NWAVES * 64) ((LAS unsigned*)(F.lds + LDSCTL_OFF))[u] = 0u;
    __syncthreads();
    const int lo = args.ph_lo, hi = args.ph_hi;
#if MK_ONE_LAUNCH
    XcdBarrier bar = xcd_barrier_post((unsigned*)(F.ctl + CW_BAR), F.MISC + 8);
#define GRID_BAR() xcd_barrier(bar)
#else
#define GRID_BAR() do {} while (0)
#endif
#define IN(k) (lo <= (k) && (k) < hi)
#define BOTH(k) (IN(k) && IN((k) + 1))
    bf16* XB = (bf16*)(ws + WS_XB); float* RSTD = (float*)(ws + WS_RSTD);
    const int bx = (int)blockIdx.x;

    if (IN(P_PRO)) { p_prologue(F); if (BOTH(P_PRO)) GRID_BAR(); }
    if (IN(G_WIN)) {
        {
            pg8::Gemm g{(const bf16*)(ws + WS_X8), (const bf16*)(ws + WS_WIN8), M, NQKV, D / 2, D / 2, D / 2, 0}; pg8::StaticOrder S; S.init(M, NQKV, F.G, bx);
            pg8::EpiWin8 E{(bf16*)(ws + WS_QKV), (bf16*)(ws + WS_Z), (bf16*)(ws + WS_GT), RSTD, (const float*)(ws + WS_SX), (const float*)(ws + WS_SW), 0};
            pg8::gemm_phase<pg8::EpiWin8, pg8::StaticOrder, true, true, true>(F.lds + RING_OFF, g, S, E);
        }
        {
            pg8::Gemm g{XB, (const bf16*)(ws + WS_WZT), M, NZP, D, D, D, 0}; pg8::StaticOrder S; S.init(M, NZP, F.G, (bx + F.G / 2) % F.G);
            pg8::EpiWin E{(bf16*)(ws + WS_QKV), (bf16*)(ws + WS_Z), (bf16*)(ws + WS_GT), RSTD, 18};
            pg8::gemm_phase<pg8::EpiWin, pg8::StaticOrder, true, true>(F.lds + RING_OFF, g, S, E);
        }
        {
            pg8::Gemm g{(const bf16*)(ws + WS_X8), (const bf16*)(ws + WS_WIN8 + (size_t)11264 * D), M, NGT, D / 2, D / 2, D / 2, 0}; pg8::StaticOrder S; S.init(M, NGT, F.G, bx);
            pg8::EpiWin8 E{(bf16*)(ws + WS_QKV), (bf16*)(ws + WS_Z), (bf16*)(ws + WS_GT), RSTD, (const float*)(ws + WS_SX), (const float*)(ws + WS_SW), 44};
            pg8::gemm_phase<pg8::EpiWin8, pg8::StaticOrder, true, true, true>(F.lds + RING_OFF, g, S, E);
        }
        if (BOTH(G_WIN)) GRID_BAR();
    }
    if (IN(T_ATTN)) { t_attn(F); __syncthreads(); t_lora_in(F); if (BOTH(T_ATTN)) GRID_BAR(); }
    if (IN(G_LORA)) {
        pg8::Gemm g{(const bf16*)(ws + WS_ALORA), (const bf16*)(ws + WS_WLORA), M, LORAN, LORAK, LORAK, LORAK, 1}; pg8::StaticOrder S; S.init(M, LORAN, F.G, bx);
        pg8::EpiLora E{(bf16*)(ws + WS_EAG), F.in[9], F.in[11], (size_t)M * 2048};
        pg8::gemm_phase<pg8::EpiLora, pg8::StaticOrder, true, true>(F.lds + RING_OFF, g, S, E);
        if (BOTH(G_LORA)) GRID_BAR();
    }
    if (IN(T_SCAN)) { t_scan1(F); if (BOTH(T_SCAN)) GRID_BAR(); }
    if (IN(T_CARRY)) {
        if (F.G >= 256) { if (bx >= 128) late_conversions(F, bx - 128, F.G - 128); } else late_conversions(F, bx, F.G);
        t_carry(F); __syncthreads(); attn_merge(F); if (BOTH(T_CARRY)) GRID_BAR(); }
    if (IN(T_FIX)) { t_fix(F); if (BOTH(T_FIX)) GRID_BAR(); }
    if (IN(G_ATTUP)) {
        pg8::Gemm g{(const bf16*)(ws + WS_ATT), (const bf16*)(ws + WS_WATT), M, D, AOW, AOW, AOW, 0}; pg8::StaticOrder S; S.init(M, D, F.G, bx);
        pg8::EpiB<2> E{(bf16*)(ws + WS_AD), D, nullptr, (const bf16*)(ws + WS_GT), nullptr, nullptr};
        pg8::gemm_phase<pg8::EpiB<2>, pg8::StaticOrder, true, true>(F.lds + RING_OFF, g, S, E);
    }
    if (IN(G_RWUP)) {
        pg8::Gemm g{(const bf16*)(ws + WS_RW), (const bf16*)(ws + WS_WRW), M, D, RWW, RWW, RWW, 0}; pg8::StaticOrder S; S.init(M, D, F.G, bx);
        pg8::EpiB<3> E{(bf16*)(ws + WS_MERGED), D, nullptr, (const bf16*)(ws + WS_GT), (const bf16*)(ws + WS_AD), (unsigned*)(ws + CTL_RMAX3)};
        pg8::gemm_phase<pg8::EpiB<3>, pg8::StaticOrder, true, true>(F.lds + RING_OFF, g, S, E);
        if (BOTH(G_RWUP)) GRID_BAR();
    }
    if (IN(G_OUT)) {
        rows_bf16_to_i8(F, (const bf16*)(ws + WS_MERGED), (const unsigned*)(ws + CTL_RMAX3), (unsigned*)(ws + WS_X8C), (float*)(ws + WS_SX3));
        GRID_BAR();
        pg8::Gemm g{(const bf16*)(ws + WS_X8C), (const bf16*)(ws + WS_W8O), M, D, D / 2, D / 2, D / 2, 0}; pg8::StaticOrder S; S.init(M, D, F.G, bx);
        pg8::EpiF<0, true> E{F.in[0], F.out, nullptr, nullptr, XB, (float*)(ws + CTL_SS2), (unsigned*)(ws + CTL_RMAX2), (const float*)(ws + WS_SX3), (const float*)(ws + WS_SWO)};
        pg8::gemm_phase<pg8::EpiF<0, true>, pg8::StaticOrder, true, true, true>(F.lds + RING_OFF, g, S, E);
        if (BOTH(G_OUT)) GRID_BAR();
    }
    if (IN(T_N2)) {
        rows_bf16_to_i8(F, XB, (const unsigned*)(ws + CTL_RMAX2), (unsigned*)(ws + WS_X8B), (float*)(ws + WS_SX2));
        transpose_matrix(F, F.in[23], DFF, D, (bf16*)(ws + WS_WMLPOUT), nullptr, 1 << 30, 0);
        quantize_matrix(F, F.in[25], D, D, (signed char*)(ws + WS_W8P), F.in[24], (const unsigned*)(ws + CTL_CMAXP), (float*)(ws + WS_SWP), 1 << 30, 0, 1 << 30);
        transpose_matrix(F, F.in[26], PLE, D, (bf16*)(ws + WS_WPLEP), nullptr, 1 << 30, 0);
        if (BOTH(T_N2)) GRID_BAR();
    }
    if (IN(G_MLPIN)) {
        pg8::Gemm g{(const bf16*)(ws + WS_X8B), (const bf16*)(ws + WS_W8M), M, DFF, D / 2, D / 2, D / 2, 0}; pg8::StaticOrder S; S.init(M, DFF, F.G, bx);
        pg8::EpiMlp8 E{(bf16*)(ws + WS_HID), DFF, (const float*)(ws + CTL_SS2), (const float*)(ws + WS_SX2), (const float*)(ws + WS_SWM)};
        pg8::gemm_phase<pg8::EpiMlp8, pg8::StaticOrder, true, true, true>(F.lds + RING_OFF, g, S, E);
        if (BOTH(G_MLPIN)) GRID_BAR();
    }
    if (IN(G_MLPOUT)) {
        pg8::Gemm g{(const bf16*)(ws + WS_HID), (const bf16*)(ws + WS_WMLPOUT), M, D, DFF, DFF, DFF, 0}; pg8::StaticOrder S; S.init(M, D, F.G, bx);
        pg8::EpiF<0> E{F.out, F.out, nullptr, nullptr, XB, (float*)(ws + CTL_SS3), (unsigned*)(ws + CTL_RMAX4), nullptr, nullptr};
        pg8::gemm_phase<pg8::EpiF<0>, pg8::StaticOrder, true, true>(F.lds + RING_OFF, g, S, E);
        if (BOTH(G_MLPOUT)) GRID_BAR();
    }
    if (IN(G_PP)) {
        rows_bf16_to_i8(F, XB, (const unsigned*)(ws + CTL_RMAX4), (unsigned*)(ws + WS_X8D), (float*)(ws + WS_SX4));
        pg8::Gemm g{(const bf16*)(ws + WS_PB), (const bf16*)(ws + WS_WPLEP), M, D, PLE, PLE, PLE, 0}; pg8::StaticOrder S; S.init(M, D, F.G, bx);
        pg8::EpiB<0> E{(bf16*)(ws + WS_PP), D, nullptr, nullptr, nullptr, nullptr};
        pg8::gemm_phase<pg8::EpiB<0>, pg8::StaticOrder, true, true>(F.lds + RING_OFF, g, S, E);
        if (BOTH(G_PP)) GRID_BAR();
    }
    if (IN(G_PLE)) {
        pg8::Gemm g{(const bf16*)(ws + WS_X8D), (const bf16*)(ws + WS_W8P), M, D, D / 2, D / 2, D / 2, 0}; pg8::StaticOrder S; S.init(M, D, F.G, bx);
        pg8::EpiF<1, true> E{F.out, F.out, (const float*)(ws + CTL_SS3), (const bf16*)(ws + WS_PP), nullptr, nullptr, nullptr, (const float*)(ws + WS_SX4), (const float*)(ws + WS_SWP)};
        pg8::gemm_phase<pg8::EpiF<1, true>, pg8::StaticOrder, true, true, true>(F.lds + RING_OFF, g, S, E);
    }
#undef IN
#undef BOTH
}

extern "C" void kernel_launch(void* const* d_in, const int* in_sizes, int n_in, void* d_out, int out_size, void* d_ws, size_t ws_size, hipStream_t stream) {
    static int grid = 0;
    if (grid == 0) {
        if (n_in != 27 || in_sizes[0] != M * D || out_size != M * D || ws_size < WS_END) { fprintf(stderr, "kernel_launch: unexpected shapes: n_in %d in0 %d out %d ws %zu (need %zu)\n", n_in, n_in > 0 ? in_sizes[0] : -1, out_size, ws_size, (size_t)WS_END); grid = -1; return; }
        int dev = 0, cus = 0, per_cu = 0;
        if (hipGetDevice(&dev) != hipSuccess || hipDeviceGetAttribute(&cus, hipDeviceAttributeMultiprocessorCount, dev) != hipSuccess) { grid = -1; return; }
        if (hipFuncSetAttribute((const void*)mk_fwd, hipFuncAttributeMaxDynamicSharedMemorySize, LDS_BYTES) != hipSuccess) { fprintf(stderr, "kernel_launch: hipFuncSetAttribute failed\n"); grid = -1; return; }
        if (hipOccupancyMaxActiveBlocksPerMultiprocessor(&per_cu, (const void*)mk_fwd, NWAVES * 64, LDS_BYTES) != hipSuccess || per_cu < 1)
            fprintf(stderr, "kernel_launch: note: occupancy query reports %d workgroups per CU\n", per_cu);
        (void)hipGetLastError();
        grid = cus;
    }
    if (grid < 0) return;
    if (hipMemsetAsync((char*)d_ws + WS_CTL, 0, CTL_ZERO_BYTES, stream) != hipSuccess) return;
    Args a{};
    for (int i = 0; i < 27; ++i) a.in[i] = (const float*)d_in[i];
    a.out = (float*)d_out; a.ws = (unsigned char*)d_ws;
#if MK_ONE_LAUNCH
    a.ph_lo = 0; a.ph_hi = NPH;
    hipLaunchKernelGGL(mk_fwd, dim3(grid), dim3(NWAVES * 64), LDS_BYTES, stream, a);
#else
    for (int ph = 0; ph < NPH; ++ph) { a.ph_lo = ph; a.ph_hi = ph + 1; hipLaunchKernelGGL(mk_fwd, dim3(grid), dim3(NWAVES * 64), LDS_BYTES, stream, a); }
#endif
}
```
